# Optimizing an MI355X kernel written in HIP

```python
import jax
import jax.numpy as jnp
from jax import lax
import numpy as np

D_MODEL = 1024
BATCH = 4
SEQ = 8192
DEPTH = 2

MLA_HEADS = 8
MLA_Q_LORA = 384
MLA_KV_LORA = 256
MLA_NOPE_DIM = 64
MLA_ROPE_DIM = 32
MLA_V_DIM = 64
MLA_WIDTH = MLA_HEADS * MLA_V_DIM
ATTN_Q_BLOCK = 128

LRU_WIDTH = 512
LRU_BLOCKS = 8
LRU_BLOCK_DIM = LRU_WIDTH // LRU_BLOCKS
LRU_CONV_WIDTH = 4
LRU_C = 8.0

RET_HEADS = 8
RET_KEY_DIM = 64
RET_VAL_DIM = 64
RET_WIDTH = RET_HEADS * RET_VAL_DIM
RET_CHUNK = 128

N_BRANCHES = 3
BRANCH_WIDTH = 512
ROPE_BASE = 10000.0
LN_EPS = 1e-5
RMS_EPS = 1e-6
DEEPNORM_ALPHA = (2 * DEPTH) ** 0.25
DEEPNORM_BETA = (8 * DEPTH) ** -0.25

IN_SIZES = (MLA_Q_LORA, MLA_KV_LORA, MLA_ROPE_DIM, MLA_WIDTH,
            LRU_WIDTH, LRU_WIDTH,
            RET_HEADS * RET_KEY_DIM, RET_HEADS * RET_KEY_DIM, RET_WIDTH, RET_WIDTH,
            N_BRANCHES * D_MODEL)
IN_COLS = sum(IN_SIZES)
IN_SPLITS = tuple(int(s) for s in np.cumsum(IN_SIZES)[:-1])

kernel_name = 'hybrid_mla_rglru_retention_deepnorm'


def _layer_norm(x, g, b):
    xf = x.astype(jnp.float32)
    mu = jnp.mean(xf, -1, keepdims=True)
    var = jnp.mean(jnp.square(xf - mu), -1, keepdims=True)
    return ((xf - mu) * lax.rsqrt(var + LN_EPS) * g + b).astype(x.dtype)


def _rms_norm(x, g):
    xf = x.astype(jnp.float32)
    return (xf * lax.rsqrt(jnp.mean(jnp.square(xf), -1, keepdims=True) + RMS_EPS) * g).astype(x.dtype)


def _rope(x, pos):
    half = x.shape[-1] // 2
    inv_freq = ROPE_BASE ** (-jnp.arange(half, dtype=jnp.float32) / half)
    ang = pos.astype(jnp.float32)[:, :, None, None] * inv_freq
    cos, sin = jnp.cos(ang), jnp.sin(ang)
    x1 = x[..., :half].astype(jnp.float32)
    x2 = x[..., half:].astype(jnp.float32)
    return jnp.concatenate([x1 * cos - x2 * sin, x2 * cos + x1 * sin], -1).astype(x.dtype)


def _causal_block_attention(q, k, v, scale):
    B, S, H, dq = q.shape
    nb = S // ATTN_Q_BLOCK
    q_blocks = q.reshape(B, nb, ATTN_Q_BLOCK, H, dq).transpose(1, 0, 2, 3, 4)
    starts = jnp.arange(nb, dtype=jnp.int32) * ATTN_Q_BLOCK
    key_idx = jnp.arange(S, dtype=jnp.int32)

    def one_block(args):
        qb, s0 = args
        s = jnp.einsum('bqhd,bkhd->bhqk', qb, k).astype(jnp.float32) * scale
        q_idx = s0 + jnp.arange(ATTN_Q_BLOCK, dtype=jnp.int32)
        mask = key_idx[None, :] <= q_idx[:, None]
        p = jax.nn.softmax(jnp.where(mask, s, -jnp.inf), axis=-1).astype(v.dtype)
        return jnp.einsum('bhqk,bkhd->bqhd', p, v)

    out = lax.map(one_block, (q_blocks, starts))
    return out.transpose(1, 0, 2, 3, 4).reshape(B, S, H, v.shape[-1])


def _mla(q_lat, kv_lat, k_pe, pos, q_norm, w_uq, kv_norm, w_ukv):
    B, S, _ = q_lat.shape
    q = jnp.einsum('bsr,re->bse', _rms_norm(q_lat, q_norm), w_uq)
    q = q.reshape(B, S, MLA_HEADS, MLA_NOPE_DIM + MLA_ROPE_DIM)
    q = jnp.concatenate([q[..., :MLA_NOPE_DIM], _rope(q[..., MLA_NOPE_DIM:], pos)], -1)
    kv = jnp.einsum('bsr,re->bse', _rms_norm(kv_lat, kv_norm), w_ukv)
    kv = kv.reshape(B, S, MLA_HEADS, MLA_NOPE_DIM + MLA_V_DIM)
    k_nope, v = kv[..., :MLA_NOPE_DIM], kv[..., MLA_NOPE_DIM:]
    k_rot = jnp.broadcast_to(_rope(k_pe[:, :, None, :], pos), (B, S, MLA_HEADS, MLA_ROPE_DIM))
    k = jnp.concatenate([k_nope, k_rot], -1)
    o = _causal_block_attention(q, k, v, (MLA_NOPE_DIM + MLA_ROPE_DIM) ** -0.5)
    return o.reshape(B, S, MLA_WIDTH)


def _rglru(u, conv_w, conv_b, w_r, b_r, w_i, b_i, lam):
    B, S, W = u.shape
    xc = lax.conv_general_dilated(u, conv_w[:, None, :], window_strides=(1,),
                                  padding=[(LRU_CONV_WIDTH - 1, 0)],
                                  dimension_numbers=('NWC', 'WIO', 'NWC'),
                                  feature_group_count=W) + conv_b
    xh = xc.reshape(B, S, LRU_BLOCKS, LRU_BLOCK_DIM)
    r = jax.nn.sigmoid(jnp.einsum('bshi,hij->bshj', xh, w_r) + b_r.reshape(LRU_BLOCKS, LRU_BLOCK_DIM)).reshape(B, S, W)
    gi = jax.nn.sigmoid(jnp.einsum('bshi,hij->bshj', xh, w_i) + b_i.reshape(LRU_BLOCKS, LRU_BLOCK_DIM)).reshape(B, S, W)
    log_a = -LRU_C * r.astype(jnp.float32) * jax.nn.softplus(-lam.astype(jnp.float32))
    a = jnp.exp(log_a)
    b = jnp.sqrt(-jnp.expm1(2.0 * log_a)) * (gi * xc).astype(jnp.float32)

    def combine(left, right):
        a1, b1 = left
        a2, b2 = right
        return a1 * a2, a2 * b1 + b2

    _, h = lax.associative_scan(combine, (a, b), axis=1)
    return h.astype(u.dtype)


def _retention(q, k, v, pos, gn_g):
    B, S, _ = q.shape
    H, C = RET_HEADS, RET_CHUNK
    N = S // C
    q = _rope(q.reshape(B, S, H, RET_KEY_DIM), pos)
    k = _rope(k.reshape(B, S, H, RET_KEY_DIM), pos) * (RET_KEY_DIM ** -0.5)
    v = v.reshape(B, S, H, RET_VAL_DIM)
    log_gamma = jnp.log1p(-jnp.exp2(-5.0 - jnp.arange(H, dtype=jnp.float32)))
    idx = jnp.arange(C, dtype=jnp.float32)
    diff = idx[:, None] - idx[None, :]
    decay = jnp.where(diff[None] >= 0, jnp.exp(diff[None] * log_gamma[:, None, None]), 0.0)
    qc = q.reshape(B, N, C, H, RET_KEY_DIM)
    kc = k.reshape(B, N, C, H, RET_KEY_DIM)
    vc = v.reshape(B, N, C, H, RET_VAL_DIM)
    scores = jnp.einsum('bnihd,bnjhd->bnhij', qc, kc) * decay.astype(q.dtype)
    inner = jnp.einsum('bnhij,bnjhe->bnihe', scores, vc)
    k_w = jnp.exp((C - 1.0 - idx)[:, None] * log_gamma[None, :])
    chunk_kv = jnp.einsum('bnjhd,bnjhe->bnhde', kc * k_w[:, :, None].astype(k.dtype), vc).astype(jnp.float32)
    chunk_decay = jnp.exp(C * log_gamma)[None, :, None, None]

    def step(state, kv_n):
        return chunk_decay * state + kv_n, state

    _, prev = lax.scan(step, jnp.zeros((B, H, RET_KEY_DIM, RET_VAL_DIM), jnp.float32),
                       jnp.moveaxis(chunk_kv, 1, 0))
    prev = jnp.moveaxis(prev, 0, 1).astype(q.dtype)
    q_w = jnp.exp((idx + 1.0)[:, None] * log_gamma[None, :])
    cross = jnp.einsum('bnihd,bnhde->bnihe', qc * q_w[:, :, None].astype(q.dtype), prev)
    o = (inner + cross).reshape(B, S, H, RET_VAL_DIM).astype(jnp.float32)
    mu = jnp.mean(o, -1, keepdims=True)
    var = jnp.mean(jnp.square(o - mu), -1, keepdims=True)
    o = (o - mu) * lax.rsqrt(var + LN_EPS) * gn_g.reshape(H, RET_VAL_DIM)
    return o.reshape(B, S, RET_WIDTH).astype(v.dtype)


def setup_inputs(seed: int = 0) -> dict:
    key = jax.random.key(seed)
    ks = jax.random.split(key, 20)
    f32 = jnp.float32

    def nrm(k, shape, scale):
        return jax.random.normal(k, shape, f32) * scale

    x = nrm(ks[0], (BATCH, SEQ, D_MODEL), 1.0)
    positions = (jnp.arange(SEQ, dtype=jnp.int32)[None, :]
                 + jax.random.randint(ks[1], (BATCH, 1), 0, 1024, dtype=jnp.int32))
    w_in = nrm(ks[2], (DEPTH, D_MODEL, IN_COLS), D_MODEL ** -0.5)
    b_merge = nrm(ks[3], (DEPTH, N_BRANCHES * D_MODEL), 0.02)
    mla_q_norm = 1.0 + nrm(ks[4], (DEPTH, MLA_Q_LORA), 0.02)
    mla_w_uq = nrm(ks[5], (DEPTH, MLA_Q_LORA, MLA_HEADS * (MLA_NOPE_DIM + MLA_ROPE_DIM)), MLA_Q_LORA ** -0.5)
    mla_kv_norm = 1.0 + nrm(ks[6], (DEPTH, MLA_KV_LORA), 0.02)
    mla_w_ukv = nrm(ks[7], (DEPTH, MLA_KV_LORA, MLA_HEADS * (MLA_NOPE_DIM + MLA_V_DIM)), MLA_KV_LORA ** -0.5)
    lru_conv_w = nrm(ks[8], (DEPTH, LRU_CONV_WIDTH, LRU_WIDTH), LRU_CONV_WIDTH ** -0.5)
    lru_conv_b = nrm(ks[9], (DEPTH, LRU_WIDTH), 0.02)
    lru_w_r = nrm(ks[10], (DEPTH, LRU_BLOCKS, LRU_BLOCK_DIM, LRU_BLOCK_DIM), LRU_BLOCK_DIM ** -0.5)
    lru_b_r = nrm(ks[11], (DEPTH, LRU_WIDTH), 0.02)
    lru_w_i = nrm(ks[12], (DEPTH, LRU_BLOCKS, LRU_BLOCK_DIM, LRU_BLOCK_DIM), LRU_BLOCK_DIM ** -0.5)
    lru_b_i = nrm(ks[13], (DEPTH, LRU_WIDTH), 0.02)
    a_c = jax.random.uniform(ks[14], (DEPTH, LRU_WIDTH), f32, minval=0.9, maxval=0.999)
    a0 = a_c ** (1.0 / LRU_C)
    lru_lambda = jnp.log(a0) - jnp.log1p(-a0)
    ret_gn_g = 1.0 + nrm(ks[15], (DEPTH, RET_WIDTH), 0.02)
    w_branch = nrm(ks[16], (DEPTH, N_BRANCHES, BRANCH_WIDTH, D_MODEL), BRANCH_WIDTH ** -0.5 * DEEPNORM_BETA)
    w_out = nrm(ks[17], (DEPTH, D_MODEL, D_MODEL), D_MODEL ** -0.5 * DEEPNORM_BETA)
    ln_g = 1.0 + nrm(ks[18], (DEPTH, D_MODEL), 0.02)
    ln_b = nrm(ks[19], (DEPTH, D_MODEL), 0.02)
    return {'x': x, 'positions': positions, 'w_in': w_in, 'b_merge': b_merge,
            'mla_q_norm': mla_q_norm, 'mla_w_uq': mla_w_uq, 'mla_kv_norm': mla_kv_norm, 'mla_w_ukv': mla_w_ukv,
            'lru_conv_w': lru_conv_w, 'lru_conv_b': lru_conv_b, 'lru_w_r': lru_w_r, 'lru_b_r': lru_b_r,
            'lru_w_i': lru_w_i, 'lru_b_i': lru_b_i, 'lru_lambda': lru_lambda, 'ret_gn_g': ret_gn_g,
            'w_branch': w_branch, 'w_out': w_out, 'ln_g': ln_g, 'ln_b': ln_b}


def reference(x, positions, w_in, b_merge, mla_q_norm, mla_w_uq, mla_kv_norm, mla_w_ukv,
              lru_conv_w, lru_conv_b, lru_w_r, lru_b_r, lru_w_i, lru_b_i, lru_lambda, ret_gn_g,
              w_branch, w_out, ln_g, ln_b):
    B, S, _ = x.shape
    for l in range(DEPTH):
        z = jnp.einsum('bsd,de->bse', x, w_in[l])
        (q_lat, kv_lat, k_pe, g_mla, lru_u, g_lru,
         r_q, r_k, r_v, g_ret, merge_logits) = jnp.split(z, IN_SPLITS, axis=-1)
        y_mla = _mla(q_lat, kv_lat, k_pe, positions, mla_q_norm[l], mla_w_uq[l],
                     mla_kv_norm[l], mla_w_ukv[l]) * jax.nn.silu(g_mla)
        y_lru = _rglru(lru_u, lru_conv_w[l], lru_conv_b[l], lru_w_r[l], lru_b_r[l],
                       lru_w_i[l], lru_b_i[l], lru_lambda[l]) * jax.nn.silu(g_lru)
        y_ret = _retention(r_q, r_k, r_v, positions, ret_gn_g[l]) * jax.nn.silu(g_ret)
        gates = jax.nn.sigmoid(merge_logits + b_merge[l]).reshape(B, S, N_BRANCHES, D_MODEL)
        mixed = (gates[:, :, 0] * jnp.einsum('bse,ed->bsd', y_mla, w_branch[l, 0])
                 + gates[:, :, 1] * jnp.einsum('bse,ed->bsd', y_lru, w_branch[l, 1])
                 + gates[:, :, 2] * jnp.einsum('bse,ed->bsd', y_ret, w_branch[l, 2]))
        out = jnp.einsum('bsd,de->bse', mixed, w_out[l])
        x = _layer_norm(DEEPNORM_ALPHA * x + out, ln_g[l], ln_b[l])
    return x
```

```cpp
#include <hip/hip_runtime.h>
#include <hip/hip_cooperative_groups.h>
#include <cstdio>
#include <cstdint>
namespace cg = cooperative_groups;
namespace pg8 {
#define PG8_LAS __attribute__((address_space(3)))
typedef unsigned short bf16_t;
typedef short bf16x8 __attribute__((ext_vector_type(8)));
typedef float f32x4 __attribute__((ext_vector_type(4)));
typedef unsigned u32x4 __attribute__((ext_vector_type(4)));
constexpr int BM = 256, BK = 64, HALF = 128, HTB = HALF * BK * 2  , STAGE_BYTES = 8 * HTB, NXCD = 8, WGM = 8;

__host__ __device__ __forceinline__ int lds_byte(int r, int c) { const int st = (r >> 4) * 2 + (c >> 5), rr = r & 15, cc = c & 31, ob = rr * 64 + cc * 2; return st * 1024 + (ob ^ (((ob >> 9) & 1) << 5)); }
__host__ __device__ __forceinline__ void stage_rc(int b, int& R, int& C) { const int st = b / 1024, sb = b % 1024, swz = sb ^ (((sb >> 9) & 1) << 5); R = (st >> 1) * 16 + swz / 64; C = (st & 1) * 32 + (swz % 64) / 2; }
__host__ __device__ __forceinline__ int perm32(int rho) { const int n = rho >> 4, i = rho & 15; return 8 * (i >> 2) + 4 * n + (i & 3); }

struct Unit { int pm, pn; };
struct Gemm { const bf16_t* A; const bf16_t* Bt; int M, N, K; };

struct StaticOrder {
    int nM, nN, nwg, G, c;
    __host__ __device__ void init(int M, int N, int G_, int c_) { nM = M / BM; nN = N / BM; nwg = nM * nN; G = G_; c = c_; }
    __host__ __device__ bool next(int i, Unit& u) const {
        const long L = (long)i * G + c; if (L >= nwg) return false;
        int wgid = (int)L; { const int q = nwg / NXCD, r = nwg % NXCD, xcd = wgid % NXCD, off = wgid / NXCD; wgid = (xcd < r ? xcd * (q + 1) : r * (q + 1) + (xcd - r) * q) + off; }
        const int nig = WGM * nN, gid = wgid / nig, fm = gid * WGM, gsz = (nM - fm) < WGM ? (nM - fm) : WGM;
        u.pm = fm + ((wgid % nig) % gsz); u.pn = (wgid % nig) / gsz; return true;
    }
    __device__ __forceinline__ void a_ready(const Unit&) const {}
    __device__ __forceinline__ void done(const Unit&) const {}
};

__device__ __forceinline__ unsigned cvt_pk_bf16(float lo, float hi) { unsigned r; asm volatile("v_cvt_pk_bf16_f32 %0, %1, %2" : "=v"(r) : "v"(lo), "v"(hi)); return r; }
template <class Epi, class Sched, bool ALIGN_EPI = false, bool SP2 = false>
__device__ __forceinline__ void gemm_phase(PG8_LAS unsigned char* lds, const Gemm g, const Sched& S, const Epi& E) {
    int tid_l = threadIdx.x; asm volatile("" : "+v"(tid_l));
    const int tid = tid_l, wid = __builtin_amdgcn_readfirstlane(tid >> 6), lane = tid & 63, wr = wid >> 2, wc = wid & 3, fr = lane & 15, fq = lane >> 4;
    const int K = g.K, nt = K / BK;
    unsigned voffA[2], voffB[2];
#pragma unroll
    for (int i = 0; i < 2; ++i) { int R, C; stage_rc(tid * 16 + i * 8192, R, C); const int Rb = Epi::PERM ? ((R & ~31) + perm32(R & 31)) : R;
        voffA[i] = (unsigned)(R * K + C) * 2u; voffB[i] = (unsigned)(Rb * K + C) * 2u; }
    const size_t kstep = (size_t)(BK * 2);
    const size_t hstep = (size_t)HALF * K * 2;
    const size_t tstep = 2 * hstep;
    const unsigned ldsw = (unsigned)wid * 1024u;
    const int aoff = lds_byte(wr * 64 + fr, fq * 8), boff = lds_byte(wc * 32 + fr, fq * 8);
#define PG8_SA(b, h) (((b) * 2 + (h)) * HTB)
#define PG8_SB(b, h) ((4 + (b) * 2 + (h)) * HTB)
#define PG8_STAGE(bufoff, gbase, voff) do { _Pragma("unroll") for (int _i = 0; _i < 2; ++_i) \
        __builtin_amdgcn_global_load_lds((const unsigned*)((const char*)(gbase) + (voff)[_i]), (PG8_LAS unsigned*)(lds + (bufoff) + ldsw + _i * 8192), 16, 0, 0); } while (0)
#define PG8_LDA(dst, b, h) do { _Pragma("unroll") for (int m = 0; m < 4; ++m) _Pragma("unroll") for (int k = 0; k < 2; ++k) dst[m][k] = *(const PG8_LAS bf16x8*)(lds + PG8_SA(b, h) + aoff + m * 2048 + k * 1024); } while (0)
#define PG8_LDB(dst, b, h) do { _Pragma("unroll") for (int n = 0; n < 2; ++n) _Pragma("unroll") for (int k = 0; k < 2; ++k) dst[n][k] = *(const PG8_LAS bf16x8*)(lds + PG8_SB(b, h) + boff + n * 2048 + k * 1024); } while (0)
#define PG8_MMA(ai, bj, At, Bt) do { __builtin_amdgcn_s_setprio(1); _Pragma("unroll") for (int m = 0; m < 4; ++m) _Pragma("unroll") for (int n = 0; n < 2; ++n) _Pragma("unroll") for (int k = 0; k < 2; ++k) \
        acc[ai][bj][m][n] = __builtin_amdgcn_mfma_f32_16x16x32_bf16(Bt[n][k], At[m][k], acc[ai][bj][m][n], 0, 0, 0); __builtin_amdgcn_s_setprio(0); } while (0)
#define PG8_WAIT_V(n) asm volatile("s_waitcnt vmcnt(" #n ")" ::: "memory")
#define PG8_WAIT_L(n) asm volatile("s_waitcnt lgkmcnt(" #n ")" ::: "memory")
#define PG8_BAR __builtin_amdgcn_s_barrier()
#define PG8_SCHED __builtin_amdgcn_sched_barrier(0)
    Unit cur, nxt; int ui = 0;
    if (!S.next(0, cur)) return;
    f32x4 acc[2][2][4][2];
#pragma unroll
    for (int a = 0; a < 2; ++a)
#pragma unroll
        for (int b = 0; b < 2; ++b)
#pragma unroll
            for (int m = 0; m < 4; ++m)
#pragma unroll
                for (int n = 0; n < 2; ++n) acc[a][b][m][n] = (f32x4){0.f, 0.f, 0.f, 0.f};
    bf16x8 At[4][2], B0[2][2], B1[2][2];
    const char* cA = (const char*)g.A + (size_t)cur.pm * tstep; const char* cB = (const char*)g.Bt + (size_t)cur.pn * tstep;
    S.a_ready(cur);
    if constexpr (SP2) {
        PG8_STAGE(PG8_SB(0, 0), cB, voffB); PG8_STAGE(PG8_SB(0, 1), cB + hstep, voffB); PG8_STAGE(PG8_SA(0, 0), cA, voffA); PG8_STAGE(PG8_SA(0, 1), cA + hstep, voffA);
        if (wr == 1) PG8_BAR;
        PG8_WAIT_V(2); PG8_BAR;
        PG8_STAGE(PG8_SB(1, 0), cB + kstep, voffB); PG8_STAGE(PG8_SA(1, 0), cA + kstep, voffA); PG8_STAGE(PG8_SB(1, 1), cB + hstep + kstep, voffB);
        PG8_WAIT_V(6); PG8_BAR;
    } else {
        PG8_STAGE(PG8_SB(0, 0), cB, voffB); PG8_STAGE(PG8_SA(0, 0), cA, voffA); PG8_STAGE(PG8_SB(0, 1), cB + hstep, voffB); PG8_STAGE(PG8_SA(0, 1), cA + hstep, voffA);
        if (wr == 1) PG8_BAR;
        PG8_WAIT_V(4); PG8_BAR;
        PG8_STAGE(PG8_SB(1, 0), cB + kstep, voffB); PG8_STAGE(PG8_SA(1, 0), cA + kstep, voffA); PG8_STAGE(PG8_SB(1, 1), cB + hstep + kstep, voffB);
        PG8_WAIT_V(6); PG8_BAR;
    }
    for (;;) {
        const bool has_next = S.next(ui + 1, nxt);
        const char* nA = has_next ? (const char*)g.A + (size_t)nxt.pm * tstep : cA; const char* nB = has_next ? (const char*)g.Bt + (size_t)nxt.pn * tstep : cB;
        for (int t = 0; t < nt; t += 2) {
            const bool last = (t == nt - 2);
            const char* a1 = cA + (size_t)(t + 1) * kstep;
            const char* a2 = last ? nA : cA + (size_t)(t + 2) * kstep; const char* b2 = last ? nB : cB + (size_t)(t + 2) * kstep;
            const char* a3 = a2 + kstep; const char* b3 = b2 + kstep;
            if (last && has_next) S.a_ready(nxt);
            if constexpr (SP2) {
            PG8_LDB(B0, 0, 0); PG8_LDB(B1, 0, 1); PG8_SCHED; PG8_LDA(At, 0, 0); PG8_STAGE(PG8_SA(1, 1), a1 + hstep, voffA);
            PG8_WAIT_V(8); PG8_WAIT_L(0); PG8_BAR; PG8_MMA(0, 0, At, B0); PG8_MMA(0, 1, At, B1); PG8_BAR; PG8_SCHED;
            PG8_LDA(At, 0, 1); PG8_STAGE(PG8_SB(0, 0), b2, voffB); PG8_STAGE(PG8_SB(0, 1), b2 + hstep, voffB); PG8_STAGE(PG8_SA(0, 0), a2, voffA);
            PG8_WAIT_V(8); PG8_WAIT_L(0); PG8_BAR; PG8_MMA(1, 0, At, B0); PG8_MMA(1, 1, At, B1); PG8_BAR; PG8_SCHED;
            PG8_LDB(B0, 1, 0); PG8_LDB(B1, 1, 1); PG8_SCHED; PG8_LDA(At, 1, 0); PG8_STAGE(PG8_SA(0, 1), a2 + hstep, voffA);
            PG8_WAIT_V(8); PG8_WAIT_L(0); PG8_BAR; PG8_MMA(0, 0, At, B0); PG8_MMA(0, 1, At, B1); PG8_BAR; PG8_SCHED;
            PG8_LDA(At, 1, 1); PG8_STAGE(PG8_SB(1, 0), b3, voffB); PG8_STAGE(PG8_SB(1, 1), b3 + hstep, voffB); PG8_STAGE(PG8_SA(1, 0), a3, voffA);
            PG8_WAIT_V(8); PG8_WAIT_L(0); PG8_BAR; PG8_MMA(1, 0, At, B0); PG8_MMA(1, 1, At, B1); PG8_BAR; PG8_SCHED;
            } else {
            PG8_LDB(B0, 0, 0); PG8_SCHED; PG8_LDA(At, 0, 0); PG8_STAGE(PG8_SA(1, 1), a1 + hstep, voffA);
            PG8_WAIT_L(8); PG8_BAR; PG8_WAIT_L(0); PG8_MMA(0, 0, At, B0); PG8_BAR; PG8_SCHED;
            PG8_LDB(B1, 0, 1); PG8_STAGE(PG8_SB(0, 0), b2, voffB);
            PG8_BAR; PG8_WAIT_L(0); PG8_MMA(0, 1, At, B1); PG8_BAR;
            PG8_LDA(At, 0, 1); PG8_STAGE(PG8_SA(0, 0), a2, voffA);
            PG8_BAR; PG8_WAIT_L(0); PG8_MMA(1, 0, At, B0); PG8_BAR; PG8_SCHED;
            PG8_STAGE(PG8_SB(0, 1), b2 + hstep, voffB);
            PG8_WAIT_V(6); PG8_BAR; PG8_MMA(1, 1, At, B1); PG8_BAR;
            PG8_LDB(B0, 1, 0); PG8_SCHED; PG8_LDA(At, 1, 0); PG8_STAGE(PG8_SA(0, 1), a2 + hstep, voffA);
            PG8_WAIT_L(8); PG8_BAR; PG8_WAIT_L(0); PG8_MMA(0, 0, At, B0); PG8_BAR; PG8_SCHED;
            PG8_LDB(B1, 1, 1); PG8_STAGE(PG8_SB(1, 0), b3, voffB);
            PG8_BAR; PG8_WAIT_L(0); PG8_MMA(0, 1, At, B1); PG8_BAR;
            PG8_LDA(At, 1, 1); PG8_STAGE(PG8_SA(1, 0), a3, voffA);
            PG8_BAR; PG8_WAIT_L(0); PG8_MMA(1, 0, At, B0); PG8_BAR; PG8_SCHED;
            PG8_STAGE(PG8_SB(1, 1), b3 + hstep, voffB);
            PG8_WAIT_V(6); PG8_BAR; PG8_MMA(1, 1, At, B1); PG8_BAR;
            }
        }
        if constexpr (ALIGN_EPI) { if (wr == 0) PG8_BAR; }
        if constexpr (!Epi::AFTER_DRAIN) { E(acc, cur, wr, wc, fr, fq); S.done(cur); }
        if (!has_next) break;
#pragma unroll
        for (int a = 0; a < 2; ++a)
#pragma unroll
            for (int b = 0; b < 2; ++b)
#pragma unroll
                for (int m = 0; m < 4; ++m)
#pragma unroll
                    for (int n = 0; n < 2; ++n) acc[a][b][m][n] = (f32x4){0.f, 0.f, 0.f, 0.f};
        cur = nxt; cA = nA; cB = nB; ++ui;
        if constexpr (ALIGN_EPI) { if (wr == 1) PG8_BAR; }
    }
    PG8_WAIT_V(0);
    if constexpr (!ALIGN_EPI) { if (wr == 0) PG8_BAR; }
    PG8_BAR;
    if constexpr (Epi::AFTER_DRAIN) { E.fused(acc, cur, wr, wc, fr, fq, lds, wid, lane); S.done(cur); }
#undef PG8_SA
#undef PG8_SB
#undef PG8_STAGE
#undef PG8_LDA
#undef PG8_LDB
#undef PG8_MMA
#undef PG8_WAIT_V
#undef PG8_WAIT_L
#undef PG8_BAR
#undef PG8_SCHED
}
}
typedef unsigned short bf16_t;
typedef short bf16x8 __attribute__((ext_vector_type(8)));
typedef short s16x4 __attribute__((ext_vector_type(4)));
typedef float f32x4 __attribute__((ext_vector_type(4)));
typedef float f32x2 __attribute__((ext_vector_type(2)));
typedef float f32x16 __attribute__((ext_vector_type(16)));
typedef unsigned u32x4 __attribute__((ext_vector_type(4)));
typedef unsigned u32x2 __attribute__((ext_vector_type(2)));
#define DI __device__ __forceinline__

constexpr int NB = 4, S = 8192, M = NB * S, DEPTH = 2;
constexpr size_t MiB = (size_t)1 << 20;
constexpr size_t W_IN = 0;
constexpr size_t W_G = W_IN + (size_t)4352 * 1024 * 2;
constexpr size_t W_UQ = W_G + (size_t)3072 * 1024 * 2;
constexpr size_t W_UKV = W_UQ + (size_t)768 * 512 * 2;
constexpr size_t W_B = W_UKV + (size_t)1024 * 256 * 2;
constexpr size_t W_O3 = W_B + (size_t)3 * 1024 * 512 * 2;
constexpr size_t W_LRU = W_O3 + (size_t)1024 * 3072 * 2;
constexpr size_t W_LAYER = W_LRU + (size_t)8 * 2 * 64 * 64 * 2;
static_assert(2 * W_LAYER <= 52 * MiB, "weights");
constexpr size_t WS_W = 0;
constexpr size_t WS_SSQ = 52 * MiB;
constexpr size_t WS_SSKV = 53 * MiB;
constexpr size_t WS_LRUS = 54 * MiB;
constexpr size_t WS_LNST = 55 * MiB;
constexpr size_t WS_BAR = 59 * MiB;
constexpr size_t WS_CKV = 60 * MiB;
constexpr size_t WS_XB = 92 * MiB;
constexpr size_t WS_ZQ = 156 * MiB;
constexpr size_t WS_GLRU = 188 * MiB;
constexpr size_t WS_RQ = 220 * MiB;
constexpr size_t WS_ZKV = 252 * MiB;
constexpr size_t WS_GMLA = 268 * MiB;
constexpr size_t WS_LRUU = 300 * MiB;
constexpr size_t WS_RK = 332 * MiB;
constexpr size_t WS_RV = 364 * MiB;
constexpr size_t WS_GRET = 396 * MiB;
constexpr size_t WS_KF = 428 * MiB;
constexpr size_t WS_V = 476 * MiB;
constexpr size_t WS_GP = 252 * MiB;
constexpr size_t WS_MIX = 444 * MiB;
constexpr size_t WS_END = 508 * MiB;
constexpr int LDS_BYTES = 136 * 1024;
#ifndef PHM
#define PHM 0xFFFF
#endif
constexpr float L2_10000 = 13.287712379549449f;
constexpr float C2Q = 0.14724444602590306f;

struct Params { const float* in[20]; float* out; unsigned char* ws; };
typedef const Params __attribute__((address_space(4)))* PP;

DI float bf2f(bf16_t v) { return __uint_as_float(((unsigned)v) << 16); }
DI unsigned pk2(float lo, float hi) { typedef __bf16 b2 __attribute__((ext_vector_type(2))); f32x2 v = {lo, hi}; b2 b = __builtin_convertvector(v, b2); return __builtin_bit_cast(unsigned, b); }
DI bf16_t f2bf(float x) { return (bf16_t)(pk2(x, 0.f) & 0xffffu); }
DI float lo16(unsigned u) { return __uint_as_float(u << 16); }
DI float hi16(unsigned u) { return __uint_as_float(u & 0xffff0000u); }
DI float sigm(float x) { return __builtin_amdgcn_rcpf(1.f + __expf(-x)); }
DI void fsincos(float ang, float& s, float& c) { const float r = __builtin_amdgcn_fractf(ang * 0.15915494309189535f); s = __builtin_amdgcn_sinf(r); c = __builtin_amdgcn_cosf(r); }
DI float ex2(float x) { return __builtin_amdgcn_exp2f(x); }
DI int crow(int r, int hi) { return (r & 3) + 8 * (r >> 2) + 4 * hi; }
#define MFMA32(a, b, c) __builtin_amdgcn_mfma_f32_32x32x16_bf16((a), (b), (c), 0, 0, 0)
#define MFMA16(a, b, c) __builtin_amdgcn_mfma_f32_16x16x32_bf16((a), (b), (c), 0, 0, 0)
#define LDS_FENCE() asm volatile("s_waitcnt lgkmcnt(0)" ::: "memory")
typedef short v4i16_t __attribute__((ext_vector_type(4)));
DI s16x4 trrd(const void* p) { return __builtin_bit_cast(s16x4, __builtin_amdgcn_ds_read_tr16_b64_v4i16((__attribute__((address_space(3))) v4i16_t*)p)); }
DI bf16x8 cat8(s16x4 lo, s16x4 hi) { return __builtin_shufflevector(lo, hi, 0, 1, 2, 3, 4, 5, 6, 7); }
DI bf16x8 pack8(float a0, float a1, float a2, float a3, float a4, float a5, float a6, float a7) { u32x4 w = {pk2(a0, a1), pk2(a2, a3), pk2(a4, a5), pk2(a6, a7)}; return __builtin_bit_cast(bf16x8, w); }

DI void cvt_job(const float* __restrict__ W, int ldw, int sc0, int k0, int kvalid, bf16_t* WT, int ldd, int drow0, int dk0, const float* kscale, float* scr, int lane) {
#pragma unroll
    for (int i = 0; i < 32; ++i) { const int kk = 2 * i + (lane >> 5), k = k0 + kk; float v = 0.f;
        if (sc0 >= 0 && k < kvalid) { v = W[(size_t)k * ldw + sc0 + (lane & 31)]; if (kscale) v *= kscale[k]; }
        scr[kk * 33 + (lane & 31)] = v; }
    LDS_FENCE();
    const int c = lane & 7;
#pragma unroll
    for (int j = 0; j < 4; ++j) { const int n = (lane >> 3) + 8 * j; const float* s = scr + (8 * c) * 33 + n;
        u32x4 o; o.x = pk2(s[0 * 33], s[1 * 33]); o.y = pk2(s[2 * 33], s[3 * 33]); o.z = pk2(s[4 * 33], s[5 * 33]); o.w = pk2(s[6 * 33], s[7 * 33]);
        *(u32x4*)(WT + (size_t)(drow0 + n) * ldd + dk0 + 8 * c) = o; }
    LDS_FENCE();
}
DI void cvt_rows_bf16(const float* __restrict__ src, bf16_t* dst, int gtid, int nthr) {
    const size_t n8 = (size_t)M * 1024 / 8;
    for (size_t i = gtid; i < n8; i += nthr) { const f32x4 a = ((const f32x4*)src)[2 * i], b = ((const f32x4*)src)[2 * i + 1];
        u32x4 o = {pk2(a.x, a.y), pk2(a.z, a.w), pk2(b.x, b.y), pk2(b.z, b.w)}; ((u32x4*)dst)[i] = o; }
}
DI void phase0(PP p, unsigned char* smem, int tid, int lane, int wave, int blk, int G) {
    float* scr = (float*)(smem + wave * 8448);
    const int gw = blk * 8 + wave, NGW = G * 8;
    constexpr int J1 = 136 * 16, J2 = 96 * 16, J3 = 24 * 8, J4 = 32 * 4, J5 = 3 * 32 * 8, J6 = 32 * 16, J7 = 32, JL = J1 + J2 + J3 + J4 + J5 + J6 + J7;
    for (int it = gw; it < DEPTH * JL; it += NGW) {
        const int l = it / JL; int r = it % JL;
        unsigned char* wl = p->ws + WS_W + (size_t)l * W_LAYER;
        const float* win = p->in[2] + (size_t)l * 1024 * 7328;
        if (r < J1) { const int g = r >> 4, kt = r & 15; int sc; if (g < 12) sc = 32 * g; else if (g == 12) sc = 640; else if (g < 16) sc = -1; else if (g < 24) sc = 384 + 32 * (g - 16); else sc = 672 + 32 * (g - 24);
            cvt_job(win, 7328, sc, 64 * kt, 1024, (bf16_t*)(wl + W_IN), 1024, 32 * g, 64 * kt, nullptr, scr, lane); continue; }
        r -= J1;
        if (r < J2) { const int g = r >> 4, kt = r & 15; cvt_job(win, 7328, 4256 + 32 * g, 64 * kt, 1024, (bf16_t*)(wl + W_G), 1024, 32 * g, 64 * kt, nullptr, scr, lane); continue; }
        r -= J2;
        if (r < J3) { const int g = r >> 3, kt = r & 7; cvt_job(p->in[5] + (size_t)l * 384 * 768, 768, 32 * g, 64 * kt, 384, (bf16_t*)(wl + W_UQ), 512, 32 * g, 64 * kt, p->in[4] + l * 384, scr, lane); continue; }
        r -= J3;
        if (r < J4) { const int g = r >> 2, kt = r & 3; const int gg = g & 15, h = gg >> 1, d0 = (gg & 1) * 32; const int sc = h * 128 + d0 + (g >= 16 ? 64 : 0);
            cvt_job(p->in[7] + (size_t)l * 256 * 1024, 1024, sc, 64 * kt, 256, (bf16_t*)(wl + W_UKV), 256, 32 * g, 64 * kt, p->in[6] + l * 256, scr, lane); continue; }
        r -= J4;
        if (r < J5) { const int br = r / 256, rr = r % 256, g = rr >> 3, kt = rr & 7;
            cvt_job(p->in[16] + (size_t)(l * 3 + br) * 512 * 1024, 1024, 32 * g, 64 * kt, 512, (bf16_t*)(wl + W_B) + (size_t)br * 1024 * 512, 512, 32 * g, 64 * kt, nullptr, scr, lane); continue; }
        r -= J5;
        if (r < J6) { const int g = r >> 4, kt = r & 15;
            cvt_job(p->in[17] + (size_t)l * 1024 * 1024, 1024, 32 * g, 64 * kt, 1024, (bf16_t*)(wl + W_O3), 1024, 32 * g, 64 * kt, nullptr, scr, lane); continue; }
        r -= J6;
        { const int h = r >> 2, gate = (r >> 1) & 1, grp = r & 1; const float* src = (gate ? p->in[12] : p->in[10]) + (size_t)(l * 8 + h) * 4096;
            cvt_job(src, 64, 32 * grp, 0, 64, (bf16_t*)(wl + W_LRU), 64, (h * 2 + gate) * 64 + 32 * grp, 0, nullptr, scr, lane); }
    }
    cvt_rows_bf16(p->in[0], (bf16_t*)(p->ws + WS_XB), blk * 512 + tid, G * 512);
}

typedef const pg8::f32x4 (&AccRef)[2][2][4][2];
struct EpiZ {
    static constexpr bool PERM = true, AFTER_DRAIN = false;
    unsigned char* ws;
    DI void operator()(AccRef acc, const pg8::Unit& u, int wr, int wc, int fr, int fq) const {
        asm volatile("" : "+v"(fr), "+v"(fq));
        const int pn = u.pn; size_t boff; int pitch, coff;
        if (pn < 2) { boff = WS_ZQ; pitch = 512; coff = 256 * pn; }
        else if (pn == 2) { boff = WS_ZKV; pitch = 256; coff = 0; }
        else { const int s = (pn - 3) >> 1; coff = 256 * ((pn - 3) & 1); pitch = 512;
            boff = s == 0 ? WS_GMLA : s == 1 ? WS_LRUU : s == 2 ? WS_GLRU : s == 3 ? WS_RQ : s == 4 ? WS_RK : s == 5 ? WS_RV : WS_GRET; }
        bf16_t* base = (bf16_t*)(ws + boff);
        float* ssq = (float*)(ws + WS_SSQ); float* sskv = (float*)(ws + WS_SSKV);
        const int row0 = u.pm * 256 + wr * 64 + fr, col0 = coff + wc * 32 + 8 * fq;
#pragma unroll
        for (int ai = 0; ai < 2; ++ai)
#pragma unroll
            for (int m = 0; m < 4; ++m) { const int row = row0 + ai * 128 + m * 16; bf16_t* rowp = base + (size_t)row * pitch + col0; float ss = 0.f;
#pragma unroll
                for (int bj = 0; bj < 2; ++bj) { const pg8::f32x4 v0 = acc[ai][bj][m][0], v1 = acc[ai][bj][m][1];
                    u32x4 w = {pk2(v0[0], v0[1]), pk2(v0[2], v0[3]), pk2(v1[0], v1[1]), pk2(v1[2], v1[3])}; *(u32x4*)(rowp + bj * 128) = w;
                    if (pn != 1 || bj == 0) ss += (v0[0] * v0[0] + v0[1] * v0[1]) + (v0[2] * v0[2] + v0[3] * v0[3]) + (v1[0] * v1[0] + v1[1] * v1[1]) + (v1[2] * v1[2] + v1[3] * v1[3]); }
                if (pn <= 2) { ss += __shfl_xor(ss, 16); ss += __shfl_xor(ss, 32);
                    if (fq == 0) { if (pn < 2) ssq[(size_t)row * 8 + pn * 4 + wc] = ss; else sskv[(size_t)row * 4 + wc] = ss; } } }
    }
};
struct EpiQ {
    static constexpr bool PERM = false, AFTER_DRAIN = false;
    const float* ssq; const int* pos; bf16_t* Q;
    DI void operator()(AccRef acc, const pg8::Unit& u, int wr, int wc, int fr, int fq) const {
        asm volatile("" : "+v"(fr), "+v"(fq));
        float invf[4];
#pragma unroll
        for (int e = 0; e < 4; ++e) invf[e] = ex2(-(float)(4 * fq + e) * (L2_10000 / 16.f));
        const int g0 = (u.pn * 256 + wc * 32) >> 5; const bool rope0 = (g0 % 3) == 2, rope1 = ((g0 + 4) % 3) == 2;
        const int row0 = u.pm * 256 + wr * 64 + fr, col0 = u.pn * 256 + wc * 32 + 4 * fq;
#pragma unroll
        for (int ai = 0; ai < 2; ++ai)
#pragma unroll
            for (int m = 0; m < 4; ++m) { const int row = row0 + ai * 128 + m * 16;
                const f32x4 s0 = *(const f32x4*)(ssq + (size_t)row * 8), s1 = *(const f32x4*)(ssq + (size_t)row * 8 + 4);
                const float ss = ((s0.x + s0.y) + (s0.z + s0.w)) + ((s1.x + s1.y) + (s1.z + s1.w));
                const float rs = rsqrtf(ss * (1.f / 384.f) + 1e-6f) * C2Q;
                float cs[4] = {1.f, 1.f, 1.f, 1.f}, sn[4] = {0.f, 0.f, 0.f, 0.f};
                if (rope0 || rope1) { const float pf = (float)pos[row];
#pragma unroll
                    for (int e = 0; e < 4; ++e) fsincos(pf * invf[e], sn[e], cs[e]); }
#pragma unroll
                for (int bj = 0; bj < 2; ++bj) { pg8::f32x4 v0 = acc[ai][bj][m][0] * rs, v1 = acc[ai][bj][m][1] * rs;
                    if (bj ? rope1 : rope0) {
#pragma unroll
                        for (int e = 0; e < 4; ++e) { const float x1 = v0[e], x2 = v1[e]; v0[e] = x1 * cs[e] - x2 * sn[e]; v1[e] = x2 * cs[e] + x1 * sn[e]; } }
                    bf16_t* dst = Q + (size_t)row * 768 + col0 + bj * 128;
                    u32x2 w0 = {pk2(v0[0], v0[1]), pk2(v0[2], v0[3])}, w1 = {pk2(v1[0], v1[1]), pk2(v1[2], v1[3])};
                    *(u32x2*)dst = w0; *(u32x2*)(dst + 16) = w1; } }
    }
};
struct EpiKV {
    static constexpr bool PERM = true, AFTER_DRAIN = false;
    const float* sskv; bf16_t* KF; bf16_t* V;
    DI void operator()(AccRef acc, const pg8::Unit& u, int wr, int wc, int fr, int fq) const {
        asm volatile("" : "+v"(fr), "+v"(fq));
        const int row0 = u.pm * 256 + wr * 64 + fr;
        const bool isk = u.pn < 2; bf16_t* base = isk ? KF : V; const int pitch = isk ? 768 : 512;
        const int c0 = u.pn * 256 + wc * 32 + 8 * fq, c1 = c0 + 128;
        const int o0 = isk ? (c0 >> 6) * 96 + (c0 & 63) : c0 - 512, o1 = isk ? (c1 >> 6) * 96 + (c1 & 63) : c1 - 512;
#pragma unroll
        for (int ai = 0; ai < 2; ++ai)
#pragma unroll
            for (int m = 0; m < 4; ++m) { const int row = row0 + ai * 128 + m * 16;
                const f32x4 s0 = *(const f32x4*)(sskv + (size_t)row * 4);
                const float rs = rsqrtf(((s0.x + s0.y) + (s0.z + s0.w)) * (1.f / 256.f) + 1e-6f);
                bf16_t* rowp = base + (size_t)row * pitch;
#pragma unroll
                for (int bj = 0; bj < 2; ++bj) { const pg8::f32x4 v0 = acc[ai][bj][m][0] * rs, v1 = acc[ai][bj][m][1] * rs;
                    u32x4 w = {pk2(v0[0], v0[1]), pk2(v0[2], v0[3]), pk2(v1[0], v1[1]), pk2(v1[2], v1[3])};
                    *(u32x4*)(rowp + (bj ? o1 : o0)) = w; } }
    }
};
struct EpiGate {
    static constexpr bool PERM = true, AFTER_DRAIN = false;
    const float* bias; bf16_t* GP;
    DI void operator()(AccRef acc, const pg8::Unit& u, int wr, int wc, int fr, int fq) const {
        asm volatile("" : "+v"(fr), "+v"(fq));
        const int row0 = u.pm * 256 + wr * 64 + fr, col0 = u.pn * 256 + wc * 32 + 8 * fq;
        f32x4 bv[2][2];
#pragma unroll
        for (int bj = 0; bj < 2; ++bj)
#pragma unroll
            for (int n = 0; n < 2; ++n) bv[bj][n] = *(const f32x4*)(bias + col0 + bj * 128 + 4 * n);
#pragma unroll
        for (int ai = 0; ai < 2; ++ai)
#pragma unroll
            for (int m = 0; m < 4; ++m) { const int row = row0 + ai * 128 + m * 16;
#pragma unroll
                for (int bj = 0; bj < 2; ++bj) { pg8::f32x4 v0 = acc[ai][bj][m][0] + bv[bj][0], v1 = acc[ai][bj][m][1] + bv[bj][1];
#pragma unroll
                    for (int e = 0; e < 4; ++e) { v0[e] = sigm(v0[e]); v1[e] = sigm(v1[e]); }
                    u32x4 w = {pk2(v0[0], v0[1]), pk2(v0[2], v0[3]), pk2(v1[0], v1[1]), pk2(v1[2], v1[3])};
                    *(u32x4*)(GP + (size_t)row * 3072 + col0 + bj * 128) = w; } }
    }
};
struct EpiP {
    static constexpr bool PERM = true, AFTER_DRAIN = false;
    const bf16_t* GP; bf16_t* MIX;
    DI void operator()(AccRef acc, const pg8::Unit& u, int wr, int wc, int fr, int fq) const {
        asm volatile("" : "+v"(fr), "+v"(fq));
        const int br = u.pn >> 2;
        const int row0 = (u.pm & 127) * 256 + wr * 64 + fr, col0 = (u.pn & 3) * 256 + wc * 32 + 8 * fq;
#pragma unroll
        for (int ai = 0; ai < 2; ++ai)
#pragma unroll
            for (int m = 0; m < 4; ++m) { const int row = row0 + ai * 128 + m * 16;
#pragma unroll
                for (int bj = 0; bj < 2; ++bj) { const pg8::f32x4 v0 = acc[ai][bj][m][0], v1 = acc[ai][bj][m][1];
                    const u32x4 g = *(const u32x4*)(GP + (size_t)row * 3072 + br * 1024 + col0 + bj * 128);
                    float o[8] = {v0[0] * lo16(g.x), v0[1] * hi16(g.x), v0[2] * lo16(g.y), v0[3] * hi16(g.y), v1[0] * lo16(g.z), v1[1] * hi16(g.z), v1[2] * lo16(g.w), v1[3] * hi16(g.w)};
                    u32x4* mp = (u32x4*)(MIX + (size_t)row * 1024 + col0 + bj * 128);
                    if (br != 0) { const u32x4 mv = *mp; o[0] += lo16(mv.x); o[1] += hi16(mv.x); o[2] += lo16(mv.y); o[3] += hi16(mv.y); o[4] += lo16(mv.z); o[5] += hi16(mv.z); o[6] += lo16(mv.w); o[7] += hi16(mv.w); }
                    u32x4 w = {pk2(o[0], o[1]), pk2(o[2], o[3]), pk2(o[4], o[5]), pk2(o[6], o[7])};
                    *mp = w; } }
    }
};
struct BrOrder {
    pg8::StaticOrder so;
    __device__ bool next(int i, pg8::Unit& u) const { const int j = i / 3, br = i - 3 * j; if (!so.next(j, u)) return false; u.pm += 128 * br; u.pn += 4 * br; return true; }
    DI void a_ready(const pg8::Unit&) const {}
    DI void done(const pg8::Unit&) const {}
};
struct EpiOut {
    static constexpr bool PERM = false, AFTER_DRAIN = false;
    const float* xin; float* out; float* lnst;
    DI void operator()(AccRef acc, const pg8::Unit& u, int wr, int wc, int fr, int fq) const {
        asm volatile("" : "+v"(fr), "+v"(fq));
        const int row0 = u.pm * 256 + wr * 64 + fr, col0 = u.pn * 256 + wc * 32 + 4 * fq;
#pragma unroll
        for (int ai = 0; ai < 2; ++ai)
#pragma unroll
            for (int m = 0; m < 4; ++m) { const int row = row0 + ai * 128 + m * 16; float s1 = 0.f, s2 = 0.f;
#pragma unroll
                for (int bj = 0; bj < 2; ++bj)
#pragma unroll
                    for (int n = 0; n < 2; ++n) { const size_t o = (size_t)row * 1024 + col0 + bj * 128 + n * 16;
                        const f32x4 xv = *(const f32x4*)(xin + o); f32x4 t;
#pragma unroll
                        for (int e = 0; e < 4; ++e) { t[e] = 1.4142135623730951f * xv[e] + acc[ai][bj][m][n][e]; s1 += t[e]; s2 += t[e] * t[e]; }
                        *(f32x4*)(out + o) = t; }
                s1 += __shfl_xor(s1, 16); s1 += __shfl_xor(s1, 32); s2 += __shfl_xor(s2, 16); s2 += __shfl_xor(s2, 32);
                if (fq == 0) { f32x2 v = {s1, s2}; *(f32x2*)(lnst + ((size_t)row * 16 + u.pn * 4 + wc) * 2) = v; } }
    }
};

DI void krot_phase(PP p, int gtid, int nthr) {
    const bf16_t* zq = (const bf16_t*)(p->ws + WS_ZQ); bf16_t* KF = (bf16_t*)(p->ws + WS_KF); const int* pos = (const int*)p->in[1];
    for (int idx = gtid; idx < M * 16; idx += nthr) { const int row = idx >> 4, j = idx & 15;
        const float x1 = bf2f(zq[(size_t)row * 512 + 384 + j]), x2 = bf2f(zq[(size_t)row * 512 + 400 + j]);
        float s_, c_; fsincos((float)pos[row] * ex2(-(float)j * (L2_10000 / 16.f)), s_, c_);
        const bf16_t o1 = f2bf(x1 * c_ - x2 * s_), o2 = f2bf(x2 * c_ + x1 * s_);
        bf16_t* d = KF + (size_t)row * 768 + 64 + j;
#pragma unroll
        for (int h = 0; h < 8; ++h) { d[h * 96] = o1; d[h * 96 + 16] = o2; } }
}

template <bool PASS2> DI void lru_pass(PP p, int l, unsigned char* smem, int tid, int lane, int wave, int blk, int G) {
    bf16_t* u_img = (bf16_t*)smem;
    bf16_t* xc_img = (bf16_t*)(smem + 19456);
    float* a_img = (float*)(smem + 19456 + 16640);
    float* b_img = a_img + 16 * 512;
    const bf16_t* U = (const bf16_t*)(p->ws + WS_LRUU); bf16_t* GY = (bf16_t*)(p->ws + WS_GLRU);
    const bf16_t* LW = (const bf16_t*)(p->ws + WS_W + (size_t)l * W_LAYER + W_LRU);
    float* SUM = (float*)(p->ws + WS_LRUS);
    const int c = tid;
    const float* cw = p->in[8] + (size_t)l * 4 * 512;
    const float cw0 = cw[c], cw1 = cw[512 + c], cw2 = cw[1024 + c], cw3 = cw[1536 + c], cb = p->in[9][l * 512 + c];
    float brv[4], biv[4], spv[4];
#pragma unroll
    for (int nt = 0; nt < 4; ++nt) { const int ch = 64 * wave + 16 * nt + (lane & 15); brv[nt] = p->in[11][l * 512 + ch]; biv[nt] = p->in[13][l * 512 + ch]; spv[nt] = 8.f * log1pf(expf(-p->in[14][l * 512 + ch])); }
    bf16x8 wrf[4][2], wif[4][2];
#pragma unroll
    for (int nt = 0; nt < 4; ++nt) {
        const bf16_t* wr_ = LW + (size_t)((wave * 2 + 0) * 64 + 16 * nt + (lane & 15)) * 64 + 8 * (lane >> 4);
        const bf16_t* wi_ = LW + (size_t)((wave * 2 + 1) * 64 + 16 * nt + (lane & 15)) * 64 + 8 * (lane >> 4);
        wrf[nt][0] = *(const bf16x8*)wr_; wrf[nt][1] = *(const bf16x8*)(wr_ + 32); wif[nt][0] = *(const bf16x8*)wi_; wif[nt][1] = *(const bf16x8*)(wi_ + 32); }
    for (int sc = blk; sc < 256; sc += G) {
        const int b = sc >> 6, n = sc & 63; const size_t row0 = (size_t)b * S + n * 128;
        float h = 0.f, Ap = 1.f;
        if (PASS2) {
            const float* sp = SUM + ((size_t)(b * 64) * 512 + c) * 2;
            for (int m0 = 0; m0 < n; m0 += 8) { f32x2 ab[8];
#pragma unroll
                for (int i = 0; i < 8; ++i) { f32x2 v = {1.f, 0.f}; if (m0 + i < n) v = *(const f32x2*)(sp + (size_t)(m0 + i) * 1024); ab[i] = v; }
#pragma unroll
                for (int i = 0; i < 8; ++i) h = ab[i].x * h + ab[i].y; } }
        u32x4 ureg[3];
#define LRU_ULOAD(T0) do { _Pragma("unroll") for (int k_ = 0; k_ < 3; ++k_) { const int i_ = tid + 512 * k_; const int r_ = i_ >> 6, cc_ = i_ & 63; const long grow_ = (long)(T0) - 3 + r_; u32x4 v_ = {0u, 0u, 0u, 0u}; \
            if (i_ < 19 * 64 && grow_ >= (long)b * S) v_ = *(const u32x4*)(U + (size_t)grow_ * 512 + cc_ * 8); ureg[k_] = v_; } } while (0)
        LRU_ULOAD(row0);
        for (int sub = 0; sub < 8; ++sub) {
            const size_t t0 = row0 + sub * 16;
#pragma unroll
            for (int k_ = 0; k_ < 3; ++k_) { const int i_ = tid + 512 * k_; if (i_ < 19 * 64) *(u32x4*)(u_img + (i_ >> 6) * 512 + (i_ & 63) * 8) = ureg[k_]; }
            __syncthreads();
            if (sub < 7) LRU_ULOAD(t0 + 16);
#pragma unroll
            for (int t = 0; t < 16; ++t) { const float xc = cb + cw0 * bf2f(u_img[t * 512 + c]) + cw1 * bf2f(u_img[(t + 1) * 512 + c]) + cw2 * bf2f(u_img[(t + 2) * 512 + c]) + cw3 * bf2f(u_img[(t + 3) * 512 + c]);
                xc_img[t * 520 + c] = f2bf(xc); }
            __syncthreads();
            {
                const bf16_t* ap = xc_img + (lane & 15) * 520 + 64 * wave + 8 * (lane >> 4);
                const bf16x8 a0 = *(const bf16x8*)ap, a1 = *(const bf16x8*)(ap + 32);
#pragma unroll
                for (int nt = 0; nt < 4; ++nt) {
                    f32x4 ar = {0.f, 0.f, 0.f, 0.f}, ai = {0.f, 0.f, 0.f, 0.f};
                    ar = MFMA16(a0, wrf[nt][0], ar); ar = MFMA16(a1, wrf[nt][1], ar);
                    ai = MFMA16(a0, wif[nt][0], ai); ai = MFMA16(a1, wif[nt][1], ai);
                    const int ch = 64 * wave + 16 * nt + (lane & 15);
#pragma unroll
                    for (int j = 0; j < 4; ++j) { const int tok = 4 * (lane >> 4) + j;
                        const float r = sigm(ar[j] + brv[nt]), gi = sigm(ai[j] + biv[nt]);
                        const float la = -r * spv[nt]; const float a = __expf(la); const float x2 = 2.f * la;
                        const float em = x2 < -0.5f ? 1.f - __expf(x2) : -x2 * (1.f + x2 * (0.5f + x2 * ((1.f / 6.f) + x2 * ((1.f / 24.f) + x2 * (1.f / 120.f)))));
                        const float mult = __builtin_amdgcn_sqrtf(em);
                        const float xcv = bf2f(xc_img[tok * 520 + ch]);
                        a_img[tok * 512 + ch] = a; b_img[tok * 512 + ch] = mult * gi * xcv; }
                }
            }
            __syncthreads();
#pragma unroll
            for (int t = 0; t < 16; ++t) { const float a = a_img[t * 512 + c], bb = b_img[t * 512 + c]; h = a * h + bb;
                if (!PASS2) Ap *= a;
                else { const size_t o = (t0 + t) * 512 + c; const float g = bf2f(GY[o]); GY[o] = f2bf(h * g * sigm(g)); } }
        }
        if (!PASS2) { f32x2 v = {Ap, h}; *(f32x2*)(SUM + ((size_t)sc * 512 + c) * 2) = v; }
        __syncthreads();
    }
}

DI void unpack8(u32x4 v, float (&f)[8]) { f[0] = lo16(v.x); f[1] = hi16(v.x); f[2] = lo16(v.y); f[3] = hi16(v.y); f[4] = lo16(v.z); f[5] = hi16(v.z); f[6] = lo16(v.w); f[7] = hi16(v.w); }
DI u32x4 packv8(const float (&f)[8]) { u32x4 w = {pk2(f[0], f[1]), pk2(f[2], f[3]), pk2(f[4], f[5]), pk2(f[6], f[7])}; return w; }
DI void ret_pass1(PP p, unsigned char* smem, int lane, int wave, int blk, int G) {
    bf16_t* Kimg = (bf16_t*)(smem + wave * 12288); bf16_t* Vimg = Kimg + 32 * 96;
    bf16_t* RQ = (bf16_t*)(p->ws + WS_RQ); bf16_t* RK = (bf16_t*)(p->ws + WS_RK); const bf16_t* RV = (const bf16_t*)(p->ws + WS_RV);
    float* CKV = (float*)(p->ws + WS_CKV); const int* pos = (const int*)p->in[1];
    const int r32 = lane & 31, hi = lane >> 5, q4 = (lane & 15) >> 2, pp = lane & 3, blk16 = (lane >> 4) & 1;
    for (int u = blk * 8 + wave; u < 2048; u += G * 8) {
        const int h = u & 7, n = (u >> 3) & 63, b = u >> 9;
        const float l2g = log2f(1.f - exp2f(-5.f - (float)h));
        const size_t rowbase = (size_t)b * S + n * 128;
        f32x16 acc[2][2];
#pragma unroll
        for (int i = 0; i < 2; ++i)
#pragma unroll
            for (int j = 0; j < 2; ++j)
#pragma unroll
                for (int r = 0; r < 16; ++r) acc[i][j][r] = 0.f;
        for (int st = 0; st < 4; ++st) {
#pragma unroll
            for (int it = 0; it < 2; ++it) {
                const int item = it * 64 + lane, tl = item >> 2, g = item & 3, d0 = 8 * g; const int tok = 32 * st + tl;
                const size_t row = rowbase + tok, off = row * 512 + 64 * h + d0;
                float q1[8], q2[8], k1[8], k2[8];
                unpack8(*(const u32x4*)(RQ + off), q1); unpack8(*(const u32x4*)(RQ + off + 32), q2);
                unpack8(*(const u32x4*)(RK + off), k1); unpack8(*(const u32x4*)(RK + off + 32), k2);
                const u32x4 v1 = *(const u32x4*)(RV + off), v2 = *(const u32x4*)(RV + off + 32);
                const float pf = (float)pos[row]; const float kw = ex2((float)(127 - tok) * l2g);
                float kw1[8], kw2[8];
#pragma unroll
                for (int jj = 0; jj < 8; ++jj) { float s_, c_; fsincos(pf * ex2(-(float)(d0 + jj) * (L2_10000 / 32.f)), s_, c_);
                    const float a = q1[jj], bq = q2[jj]; q1[jj] = a * c_ - bq * s_; q2[jj] = bq * c_ + a * s_;
                    const float ck = k1[jj], dk = k2[jj]; k1[jj] = (ck * c_ - dk * s_) * 0.125f; k2[jj] = (dk * c_ + ck * s_) * 0.125f;
                    kw1[jj] = k1[jj] * kw; kw2[jj] = k2[jj] * kw; }
                *(u32x4*)(RQ + off) = packv8(q1); *(u32x4*)(RQ + off + 32) = packv8(q2);
                *(u32x4*)(RK + off) = packv8(k1); *(u32x4*)(RK + off + 32) = packv8(k2);
                *(u32x4*)(Kimg + tl * 96 + d0) = packv8(kw1); *(u32x4*)(Kimg + tl * 96 + d0 + 32) = packv8(kw2);
                *(u32x4*)(Vimg + tl * 96 + d0) = v1; *(u32x4*)(Vimg + tl * 96 + d0 + 32) = v2;
            }
            LDS_FENCE();
#pragma unroll
            for (int ks = 0; ks < 2; ++ks) {
                const int rowk = 16 * ks + 8 * hi;
                bf16x8 af[2], bfr[2];
#pragma unroll
                for (int x = 0; x < 2; ++x) { const int co = 32 * x + 16 * blk16 + 4 * pp;
                    af[x] = cat8(trrd(Kimg + (rowk + q4) * 96 + co), trrd(Kimg + (rowk + 4 + q4) * 96 + co));
                    bfr[x] = cat8(trrd(Vimg + (rowk + q4) * 96 + co), trrd(Vimg + (rowk + 4 + q4) * 96 + co)); }
#pragma unroll
                for (int dh = 0; dh < 2; ++dh)
#pragma unroll
                    for (int eh = 0; eh < 2; ++eh) acc[dh][eh] = MFMA32(af[dh], bfr[eh], acc[dh][eh]);
            }
            LDS_FENCE();
        }
        float* dst = CKV + ((size_t)(b * 64 + n) * 8 + h) * 4096;
#pragma unroll
        for (int dh = 0; dh < 2; ++dh)
#pragma unroll
            for (int eh = 0; eh < 2; ++eh)
#pragma unroll
                for (int r = 0; r < 16; ++r) dst[(32 * dh + crow(r, hi)) * 64 + 32 * eh + r32] = acc[dh][eh][r];
    }
}
DI void ret_prefix(PP p, int gtid, int nthr) {
    float* CKV = (float*)(p->ws + WS_CKV);
    for (int idx = gtid; idx < NB * 8 * 4096; idx += nthr) { const int de = idx & 4095, h = (idx >> 12) & 7, b = idx >> 15;
        const float decay = exp2f(128.f * log2f(1.f - exp2f(-5.f - (float)h)));
        float* base = CKV + ((size_t)b * 64 * 8 + h) * 4096 + de; float s = 0.f;
        for (int n0 = 0; n0 < 64; n0 += 8) { float t[8];
#pragma unroll
            for (int i = 0; i < 8; ++i) t[i] = base[(size_t)(n0 + i) * 8 * 4096];
#pragma unroll
            for (int i = 0; i < 8; ++i) { base[(size_t)(n0 + i) * 8 * 4096] = s; s = decay * s + t[i]; } } }
}

DI void attn_step64(const unsigned char* Kb, const unsigned char* Vb, const bf16x8 (&qf)[6], f32x16& o0, f32x16& o1, float& mrun, float& lsum, int k0, int q, bool masked, int r32, int hi, int q4, int pp, int blk16) {
    f32x16 p0, p1;
#pragma unroll
    for (int i = 0; i < 16; ++i) { p0[i] = 0.f; p1[i] = 0.f; }
#pragma unroll
    for (int d0 = 0; d0 < 6; ++d0) { const bf16x8 ka = *(const bf16x8*)(Kb + r32 * 208 + (16 * d0 + 8 * hi) * 2), kb = *(const bf16x8*)(Kb + (32 + r32) * 208 + (16 * d0 + 8 * hi) * 2);
        p0 = MFMA32(ka, qf[d0], p0); p1 = MFMA32(kb, qf[d0], p1); }
    if (masked) {
#pragma unroll
        for (int i = 0; i < 16; ++i) { const int key = k0 + crow(i, hi); if (key > q) p0[i] = -INFINITY; if (key + 32 > q) p1[i] = -INFINITY; } }
    float mx = fmaxf(p0[0], p1[0]);
#pragma unroll
    for (int i = 1; i < 16; ++i) mx = fmaxf(mx, fmaxf(p0[i], p1[i]));
    mx = fmaxf(mx, __shfl_xor(mx, 32));
    const float mn = fmaxf(mrun, mx); const float alpha = ex2(mrun - mn); mrun = mn;
    float ps = 0.f;
#pragma unroll
    for (int i = 0; i < 16; ++i) { p0[i] = ex2(p0[i] - mn); p1[i] = ex2(p1[i] - mn); ps += p0[i] + p1[i]; }
    lsum = lsum * alpha + ps;
#pragma unroll
    for (int i = 0; i < 16; ++i) { o0[i] *= alpha; o1[i] *= alpha; }
#pragma unroll
    for (int s = 0; s < 4; ++s) {
        bf16x8 pb;
        if (s == 0) pb = pack8(p0[0], p0[1], p0[2], p0[3], p0[4], p0[5], p0[6], p0[7]);
        else if (s == 1) pb = pack8(p0[8], p0[9], p0[10], p0[11], p0[12], p0[13], p0[14], p0[15]);
        else if (s == 2) pb = pack8(p1[0], p1[1], p1[2], p1[3], p1[4], p1[5], p1[6], p1[7]);
        else pb = pack8(p1[8], p1[9], p1[10], p1[11], p1[12], p1[13], p1[14], p1[15]);
        const int rowk = 16 * s + 4 * hi; const int co = (16 * blk16 + 4 * pp) * 2;
        const bf16x8 va0 = cat8(trrd(Vb + (rowk + q4) * 192 + co), trrd(Vb + (rowk + 8 + q4) * 192 + co));
        const bf16x8 va1 = cat8(trrd(Vb + (rowk + q4) * 192 + 64 + co), trrd(Vb + (rowk + 8 + q4) * 192 + 64 + co));
        o0 = MFMA32(va0, pb, o0); o1 = MFMA32(va1, pb, o1);
    }
}
#ifndef ATTN_SB
#define ATTN_SB() ((void)0)
#endif
#define PK8(P, B) pack8(P[B], P[B + 1], P[B + 2], P[B + 3], P[B + 4], P[B + 5], P[B + 6], P[B + 7])
DI void attn_phase(PP p, unsigned char* smem, int tid, int lane, int wave, int blk, int G) {
    const bf16_t* Q = (const bf16_t*)(p->ws + WS_XB); const bf16_t* KF = (const bf16_t*)(p->ws + WS_KF); const bf16_t* V = (const bf16_t*)(p->ws + WS_V);
    const bf16_t* GM = (const bf16_t*)(p->ws + WS_GMLA); bf16_t* Y = (bf16_t*)(p->ws + WS_ZQ);
    const int r32 = lane & 31, hi = lane >> 5, q4 = (lane & 15) >> 2, pp = lane & 3, blk16 = (lane >> 4) & 1;
    constexpr int KBUF = 128 * 208, VBUF = 128 * 192, VOFF = 2 * KBUF;
    int kro[3], klo[3];
#pragma unroll
    for (int i = 0; i < 3; ++i) { const int c = tid + 512 * i; kro[i] = (c / 12) * 768 + (c % 12) * 8; klo[i] = (c / 12) * 208 + (c % 12) * 16; }
    int vro[2], vlo[2];
#pragma unroll
    for (int i = 0; i < 2; ++i) { const int c = tid + 512 * i; vro[i] = (c >> 3) * 512 + (c & 7) * 8; vlo[i] = (c >> 3) * 192 + (c & 7) * 16; }
    for (int u = blk; u < 1024; u += G) {
        const int r = u & 255, i4 = u >> 8; const int bh = (r & 7) * 4 + ((r >> 3) >> 3), jj = (r >> 3) & 7;
        const int qb = i4 == 0 ? 31 - jj : i4 == 1 ? 16 + jj : i4 == 2 ? 15 - jj : jj;
        const int b = bh >> 3, h = bh & 7;
        const size_t rowb = (size_t)b * S; const int q0 = qb * 256, qw0 = q0 + wave * 32; const int NT = 2 * qb + 2;
        bf16x8 qf[6];
#pragma unroll
        for (int d0 = 0; d0 < 6; ++d0) qf[d0] = *(const bf16x8*)(Q + (rowb + qw0 + r32) * 768 + h * 96 + 16 * d0 + 8 * hi);
        f32x16 o0, o1;
#pragma unroll
        for (int i = 0; i < 16; ++i) { o0[i] = 0.f; o1[i] = 0.f; }
        float mrun = -INFINITY, lsum = 0.f;
        const bf16_t* kbase = KF + rowb * 768 + h * 96; const bf16_t* vbase = V + rowb * 512 + h * 64;
        u32x4 kg[3], vg[2];
#pragma unroll
        for (int i = 0; i < 3; ++i) kg[i] = *(const u32x4*)(kbase + kro[i]);
#pragma unroll
        for (int i = 0; i < 2; ++i) vg[i] = *(const u32x4*)(vbase + vro[i]);
#pragma unroll
        for (int i = 0; i < 3; ++i) *(u32x4*)(smem + klo[i]) = kg[i];
#pragma unroll
        for (int i = 0; i < 2; ++i) *(u32x4*)(smem + VOFF + vlo[i]) = vg[i];
        __syncthreads();
        for (int kt = 0; kt < NT; ++kt) {
            const int cur = kt & 1; const bool more = kt + 1 < NT;
            if (more) { const bf16_t* kn = kbase + (size_t)(kt + 1) * 128 * 768; const bf16_t* vn = vbase + (size_t)(kt + 1) * 128 * 512;
#pragma unroll
                for (int i = 0; i < 3; ++i) kg[i] = *(const u32x4*)(kn + kro[i]);
#pragma unroll
                for (int i = 0; i < 2; ++i) vg[i] = *(const u32x4*)(vn + vro[i]); }
            const unsigned char* Kb = smem + cur * KBUF; const unsigned char* Vb = smem + VOFF + cur * VBUF;
            const int k0 = kt * 128;
            if (kt > 0 && k0 + 127 <= qw0) {
                f32x16 negm;
#pragma unroll
                for (int i = 0; i < 16; ++i) negm[i] = -mrun;
                f32x16 pa0, pa1, pb0, pb1;
#pragma unroll
                for (int d0 = 0; d0 < 6; ++d0) { const unsigned char* kp = Kb + r32 * 208 + (16 * d0 + 8 * hi) * 2;
                    const bf16x8 k0f = *(const bf16x8*)kp, k1f = *(const bf16x8*)(kp + 32 * 208);
                    pa0 = MFMA32(k0f, qf[d0], d0 == 0 ? negm : pa0); pa1 = MFMA32(k1f, qf[d0], d0 == 0 ? negm : pa1); }
                float ps = 0.f;
                const int co = (16 * blk16 + 4 * pp) * 2;
#pragma unroll
                for (int s = 0; s < 8; ++s) {
                    ATTN_SB();
                    float e[8];
#pragma unroll
                    for (int j = 0; j < 8; ++j) { const int ix = (s & 1) * 8 + j; const float v = (s >> 1) == 0 ? pa0[ix] : (s >> 1) == 1 ? pa1[ix] : (s >> 1) == 2 ? pb0[ix] : pb1[ix]; e[j] = ex2(v); ps += e[j]; }
                    const bf16x8 pk = pack8(e[0], e[1], e[2], e[3], e[4], e[5], e[6], e[7]);
                    if (s < 4) {
#pragma unroll
                        for (int t = 0; t < 3; ++t) { const int m = 3 * s + t, d0 = m >> 1, wh = m & 1;
                            const bf16x8 kf = *(const bf16x8*)(Kb + (64 + 32 * wh + r32) * 208 + (16 * d0 + 8 * hi) * 2);
                            if (wh == 0) pb0 = MFMA32(kf, qf[d0], d0 == 0 ? negm : pb0); else pb1 = MFMA32(kf, qf[d0], d0 == 0 ? negm : pb1); } }
                    const int rowk = 16 * s + 4 * hi;
                    const bf16x8 va0 = cat8(trrd(Vb + (rowk + q4) * 192 + co), trrd(Vb + (rowk + 8 + q4) * 192 + co));
                    const bf16x8 va1 = cat8(trrd(Vb + (rowk + q4) * 192 + 64 + co), trrd(Vb + (rowk + 8 + q4) * 192 + 64 + co));
                    o0 = MFMA32(va0, pk, o0); o1 = MFMA32(va1, pk, o1);
                }
                lsum += ps;
                const float pr = ps + __shfl_xor(ps, 32);
                if (__any(pr > 65536.f)) { const float d = pr > 65536.f ? floorf(__log2f(pr)) : 0.f; mrun += d; const float sc = ex2(-d); lsum *= sc;
#pragma unroll
                    for (int i = 0; i < 16; ++i) { o0[i] *= sc; o1[i] *= sc; } }
            } else {
#pragma unroll
                for (int sub = 0; sub < 2; ++sub) { const int ks = k0 + 64 * sub;
                    if (ks <= qw0 + 31) attn_step64(Kb + sub * 64 * 208, Vb + sub * 64 * 192, qf, o0, o1, mrun, lsum, ks, qw0 + r32, ks + 63 > qw0, r32, hi, q4, pp, blk16); }
            }
            if (more) { unsigned char* Kn = smem + (cur ^ 1) * KBUF; unsigned char* Vn = smem + VOFF + (cur ^ 1) * VBUF;
#pragma unroll
                for (int i = 0; i < 3; ++i) *(u32x4*)(Kn + klo[i]) = kg[i];
#pragma unroll
                for (int i = 0; i < 2; ++i) *(u32x4*)(Vn + vlo[i]) = vg[i]; }
            __syncthreads();
        }
        const float lt = lsum + __shfl_xor(lsum, 32); const float inv = 1.f / lt;
        const size_t row = rowb + qw0 + r32;
#pragma unroll
        for (int dvh = 0; dvh < 2; ++dvh)
#pragma unroll
            for (int g4 = 0; g4 < 4; ++g4) { const int dv = 32 * dvh + 8 * g4 + 4 * hi; const size_t o = row * 512 + h * 64 + dv;
                const u32x2 gv = *(const u32x2*)(GM + o); float g[4] = {lo16(gv.x), hi16(gv.x), lo16(gv.y), hi16(gv.y)}; float y[4];
#pragma unroll
                for (int j = 0; j < 4; ++j) { const float ov = (dvh ? o1[4 * g4 + j] : o0[4 * g4 + j]) * inv; y[j] = ov * g[j] * sigm(g[j]); }
                u32x2 w = {pk2(y[0], y[1]), pk2(y[2], y[3])}; *(u32x2*)(Y + o) = w; }
    }
}

DI void ret_pass2(PP p, int l, unsigned char* smem, int lane, int wave, int blk, int G) {
    bf16_t* Vimg = (bf16_t*)(smem + wave * 6144);
    bf16_t* RQ = (bf16_t*)(p->ws + WS_RQ); const bf16_t* RK = (const bf16_t*)(p->ws + WS_RK); const bf16_t* RV = (const bf16_t*)(p->ws + WS_RV);
    const bf16_t* GR = (const bf16_t*)(p->ws + WS_GRET); const float* CKV = (const float*)(p->ws + WS_CKV); const float* gng = p->in[15] + l * 512;
    const int r32 = lane & 31, hi = lane >> 5, q4 = (lane & 15) >> 2, pp = lane & 3, blk16 = (lane >> 4) & 1;
    for (int u = blk * 8 + wave; u < 2048; u += G * 8) {
        const int h = u & 7, n = (u >> 3) & 63, b = u >> 9;
        const float l2g = log2f(1.f - exp2f(-5.f - (float)h));
        const size_t rowbase = (size_t)b * S + n * 128;
        const float* prev = CKV + ((size_t)(b * 64 + n) * 8 + h) * 4096;
        bf16x8 pf[2][4];
#pragma unroll
        for (int eh = 0; eh < 2; ++eh)
#pragma unroll
            for (int ks = 0; ks < 4; ++ks) { const float* s = prev + (16 * ks + 8 * hi) * 64 + 32 * eh + r32;
                pf[eh][ks] = pack8(s[0], s[64], s[128], s[192], s[256], s[320], s[384], s[448]); }
        for (int it = 0; it < 4; ++it) {
            f32x16 oT[2];
#pragma unroll
            for (int r = 0; r < 16; ++r) { oT[0][r] = 0.f; oT[1][r] = 0.f; }
            const size_t qrow = rowbase + 32 * it + r32;
            bf16x8 qf[4];
#pragma unroll
            for (int ks = 0; ks < 4; ++ks) qf[ks] = *(const bf16x8*)(RQ + qrow * 512 + 64 * h + 16 * ks + 8 * hi);
            for (int jt = 0; jt <= it; ++jt) {
#pragma unroll
                for (int c4 = 0; c4 < 4; ++c4) { const int idx = c4 * 64 + lane, tl = idx >> 3, cc = idx & 7;
                    *(u32x4*)(Vimg + tl * 96 + cc * 8) = *(const u32x4*)(RV + (rowbase + 32 * jt + tl) * 512 + 64 * h + cc * 8); }
                f32x16 sT;
#pragma unroll
                for (int r = 0; r < 16; ++r) sT[r] = 0.f;
                const size_t krow = rowbase + 32 * jt + r32;
#pragma unroll
                for (int ks = 0; ks < 4; ++ks) { const bf16x8 kf = *(const bf16x8*)(RK + krow * 512 + 64 * h + 16 * ks + 8 * hi); sT = MFMA32(kf, qf[ks], sT); }
                const int il = 32 * it + r32;
#pragma unroll
                for (int r = 0; r < 16; ++r) { const int dd = il - (32 * jt + crow(r, hi)); sT[r] = dd >= 0 ? sT[r] * ex2((float)dd * l2g) : 0.f; }
                LDS_FENCE();
#pragma unroll
                for (int s = 0; s < 2; ++s) {
                    const bf16x8 pb = s == 0 ? pack8(sT[0], sT[1], sT[2], sT[3], sT[4], sT[5], sT[6], sT[7]) : pack8(sT[8], sT[9], sT[10], sT[11], sT[12], sT[13], sT[14], sT[15]);
                    const int rowk = 16 * s + 4 * hi;
#pragma unroll
                    for (int eh = 0; eh < 2; ++eh) { const int co = 32 * eh + 16 * blk16 + 4 * pp;
                        const bf16x8 va = cat8(trrd(Vimg + (rowk + q4) * 96 + co), trrd(Vimg + (rowk + 8 + q4) * 96 + co));
                        oT[eh] = MFMA32(va, pb, oT[eh]); }
                }
                LDS_FENCE();
            }
            f32x16 cT[2];
#pragma unroll
            for (int r = 0; r < 16; ++r) { cT[0][r] = 0.f; cT[1][r] = 0.f; }
#pragma unroll
            for (int eh = 0; eh < 2; ++eh)
#pragma unroll
                for (int ks = 0; ks < 4; ++ks) cT[eh] = MFMA32(pf[eh][ks], qf[ks], cT[eh]);
            const float qw = ex2((float)(32 * it + r32 + 1) * l2g);
            float s1 = 0.f;
#pragma unroll
            for (int r = 0; r < 16; ++r) { oT[0][r] += qw * cT[0][r]; oT[1][r] += qw * cT[1][r]; s1 += oT[0][r] + oT[1][r]; }
            s1 += __shfl_xor(s1, 32); const float mu = s1 * (1.f / 64.f);
            float s2 = 0.f;
#pragma unroll
            for (int r = 0; r < 16; ++r) { const float d0 = oT[0][r] - mu, d1 = oT[1][r] - mu; s2 += d0 * d0 + d1 * d1; }
            s2 += __shfl_xor(s2, 32); const float rstd = rsqrtf(s2 * (1.f / 64.f) + 1e-5f);
#pragma unroll
            for (int eh = 0; eh < 2; ++eh)
#pragma unroll
                for (int g4 = 0; g4 < 4; ++g4) { const int e = 32 * eh + 8 * g4 + 4 * hi; const size_t o = qrow * 512 + 64 * h + e;
                    const f32x4 gn = *(const f32x4*)(gng + 64 * h + e); const u32x2 gv = *(const u32x2*)(GR + o);
                    const float g[4] = {lo16(gv.x), hi16(gv.x), lo16(gv.y), hi16(gv.y)}; float y[4];
#pragma unroll
                    for (int j = 0; j < 4; ++j) y[j] = (oT[eh][4 * g4 + j] - mu) * rstd * gn[j] * g[j] * sigm(g[j]);
                    u32x2 w = {pk2(y[0], y[1]), pk2(y[2], y[3])}; *(u32x2*)(RQ + o) = w; }
        }
    }
}

DI void ln_phase(PP p, int l, bool write_xb, int lane, int wave, int blk, int G) {
    float* out = p->out; const float* lnst = (const float*)(p->ws + WS_LNST); bf16_t* XB = (bf16_t*)(p->ws + WS_XB);
    const float* g = p->in[18] + l * 1024; const float* bb = p->in[19] + l * 1024;
    for (int row = blk * 8 + wave; row < M; row += G * 8) {
        float s1 = 0.f, s2 = 0.f;
        if (lane < 16) { const f32x2 v = *(const f32x2*)(lnst + ((size_t)row * 16 + lane) * 2); s1 = v.x; s2 = v.y; }
#pragma unroll
        for (int o = 1; o < 16; o <<= 1) { s1 += __shfl_xor(s1, o); s2 += __shfl_xor(s2, o); }
        s1 = __shfl(s1, 0); s2 = __shfl(s2, 0);
        const float mean = s1 * (1.f / 1024.f); const float var = fmaxf(s2 * (1.f / 1024.f) - mean * mean, 0.f); const float rstd = rsqrtf(var + 1e-5f);
#pragma unroll
        for (int j = 0; j < 4; ++j) { const int c = 4 * lane + 256 * j; const size_t o = (size_t)row * 1024 + c;
            const f32x4 t = *(const f32x4*)(out + o), gv = *(const f32x4*)(g + c), bv = *(const f32x4*)(bb + c); f32x4 y;
#pragma unroll
            for (int e = 0; e < 4; ++e) y[e] = (t[e] - mean) * rstd * gv[e] + bv[e];
            *(f32x4*)(out + o) = y;
            if (write_xb) { u32x2 w = {pk2(y[0], y[1]), pk2(y[2], y[3])}; *(u32x2*)(XB + o) = w; } }
    }
}

#define XLAS __attribute__((address_space(3)))
#define XB_TMO      128
#define XB_XCNT(j)  (256  + 64 * (j))
#define XB_XSUB(j)  (1280 + 64 * (j))
#define XB_XGEN(j)  (2304 + 64 * (j))
#define XB_TOP      3328
#define XB_TOPGEN   3392
#define XCD_BAR_WORDS 3456
#define XB_SPIN_CAP (1u << 18)

__device__ __forceinline__ unsigned xb_ld(unsigned* p)              { return __hip_atomic_load(p, __ATOMIC_RELAXED, __HIP_MEMORY_SCOPE_AGENT); }
__device__ __forceinline__ unsigned xb_add(unsigned* p, unsigned v) { return __hip_atomic_fetch_add(p, v, __ATOMIC_RELAXED, __HIP_MEMORY_SCOPE_AGENT); }
__device__ __forceinline__ unsigned xb_xcc_id() { return (unsigned)__builtin_amdgcn_s_getreg((3 << 11) | 20) & 0xFu; }
#define XB_SPIN(cond, bar) do { unsigned _sp = 0; while (cond) { __builtin_amdgcn_s_sleep(1); \
    if ((++_sp & 255u) == 0u) { if (xb_ld(&(bar)[XB_TMO])) break; if (_sp > XB_SPIN_CAP) { atomicAdd(&(bar)[XB_TMO], 1u); break; } } } } while (0)

struct XcdBarrier {
    unsigned* bar; unsigned x;
    volatile XLAS unsigned* st;
};

__device__ __forceinline__ XcdBarrier xcd_barrier_post(unsigned* bar, volatile XLAS unsigned* st) {
    XcdBarrier b; b.bar = bar; b.x = xb_xcc_id(); b.st = st;
    if (threadIdx.x == 0) (void)xb_add(&bar[XB_XCNT(b.x)], 1u);
    return b;
}
__device__ __forceinline__ void xcd_barrier_complete(unsigned* bar, unsigned x, unsigned& nloc, unsigned& nx) {
    const unsigned G = gridDim.x * gridDim.y * gridDim.z;
    unsigned sum, cnt, mine, sp = 0u;
    for (;;) {
        sum = 0u; cnt = 0u; mine = 0u;
#pragma unroll
        for (unsigned j = 0; j < 16; ++j) { const unsigned c = xb_ld(&bar[XB_XCNT(j)]); sum += c; cnt += (c > 0u) ? 1u : 0u; mine = (j == x) ? c : mine; }
        if (sum == G) break;
        __builtin_amdgcn_s_sleep(1);
        if ((++sp & 255u) == 0u) { if (xb_ld(&bar[XB_TMO])) break; if (sp > XB_SPIN_CAP) { atomicAdd(&bar[XB_TMO], 1u); break; } }
    }
    nloc = mine > 0u ? mine : 1u; nx = cnt > 0u ? cnt : 1u;
}

__device__ __forceinline__ void xcd_barrier(const XcdBarrier& b) {
    asm volatile("s_waitcnt vmcnt(0)" ::: "memory");
    __syncthreads();
    if (threadIdx.x == 0) {
        unsigned* bar = b.bar;
        __builtin_amdgcn_s_waitcnt(0);
        unsigned nloc = b.st[0], nx = b.st[1];
        if (nloc == 0u) { xcd_barrier_complete(bar, b.x, nloc, nx); b.st[0] = nloc; b.st[1] = nx; }
        const unsigned old = xb_add(&bar[XB_XSUB(b.x)], 1u);
        const unsigned gen = old / nloc;
        if (old + 1u == (gen + 1u) * nloc) {
            __builtin_amdgcn_fence(__ATOMIC_RELEASE, "agent");
            asm volatile("s_waitcnt vmcnt(0)" ::: "memory");
            const unsigned og = xb_add(&bar[XB_TOP], 1u);
            const unsigned tg = og / nx;
            if (og + 1u == (tg + 1u) * nx) xb_add(&bar[XB_TOPGEN], 1u);
            else XB_SPIN(xb_ld(&bar[XB_TOPGEN]) == tg, bar);
            __builtin_amdgcn_fence(__ATOMIC_ACQUIRE, "agent");
            xb_add(&bar[XB_XGEN(b.x)], 1u);
            asm volatile("s_waitcnt vmcnt(0)" ::: "memory");
        } else {
            XB_SPIN(xb_ld(&bar[XB_XGEN(b.x)]) == gen, bar);
            __builtin_amdgcn_fence(__ATOMIC_ACQUIRE, "agent");
            asm volatile("s_waitcnt vmcnt(0)" ::: "memory");
        }
    }
    __syncthreads();
}


#define PH() do { asm volatile("" : "+v"(tid)); asm volatile("" : "+s"(q)); ws = q->ws; lane = tid & 63; wave = __builtin_amdgcn_readfirstlane(tid >> 6); } while (0)
template <int l> DI void run_layer(unsigned char* smem, const XcdBarrier& xbar) {
    int tid = threadIdx.x, lane = tid & 63, wave = __builtin_amdgcn_readfirstlane(tid >> 6);
    const int G = gridDim.x, blk = blockIdx.x;
    PG8_LAS unsigned char* glds = (PG8_LAS unsigned char*)smem;
    PP q = (PP)__builtin_amdgcn_kernarg_segment_ptr();
    unsigned char* ws = q->ws;
        const unsigned char* wl = ws + WS_W + (size_t)l * W_LAYER;
        const float* xcur = (l == 0) ? q->in[0] : q->out;
        PH(); if (PHM & 2) { pg8::Gemm g{(const bf16_t*)(ws + WS_XB), (const bf16_t*)(wl + W_IN), M, 4352, 1024}; pg8::StaticOrder so; so.init(M, 4352, G, blk);
          EpiZ E{ws}; pg8::gemm_phase<EpiZ, pg8::StaticOrder, true, true>(glds, g, so, E); }
        xcd_barrier(xbar);
        PH(); if (PHM & 4) { pg8::Gemm g{(const bf16_t*)(ws + WS_ZQ), (const bf16_t*)(wl + W_UQ), M, 768, 512}; pg8::StaticOrder so; so.init(M, 768, G, blk);
          EpiQ E{(const float*)(ws + WS_SSQ), (const int*)q->in[1], (bf16_t*)(ws + WS_XB)}; pg8::gemm_phase<EpiQ, pg8::StaticOrder, true, true>(glds, g, so, E); }
        PH(); if (PHM & 8) { pg8::Gemm g{(const bf16_t*)(ws + WS_ZKV), (const bf16_t*)(wl + W_UKV), M, 1024, 256}; pg8::StaticOrder so; so.init(M, 1024, G, blk);
          EpiKV E{(const float*)(ws + WS_SSKV), (bf16_t*)(ws + WS_KF), (bf16_t*)(ws + WS_V)}; pg8::gemm_phase<EpiKV, pg8::StaticOrder, true, true>(glds, g, so, E); }
        __syncthreads();
        PH(); if (PHM & 16) krot_phase(q, blk * 512 + tid, G * 512);
        PH(); if (PHM & 32) lru_pass<false>(q, l, smem, tid, lane, wave, blk, G);
        __syncthreads();
        PH(); if (PHM & 64) ret_pass1(q, smem, lane, wave, blk, G);
        xcd_barrier(xbar);
        PH(); if (PHM & 128) ret_prefix(q, blk * 512 + tid, G * 512);
        PH(); if (PHM & 256) lru_pass<true>(q, l, smem, tid, lane, wave, blk, G);
        __syncthreads();
        PH(); if (PHM & 512) attn_phase(q, smem, tid, lane, wave, blk, G);
        xcd_barrier(xbar);
        PH(); if (PHM & 1024) ret_pass2(q, l, smem, lane, wave, blk, G);
        cvt_rows_bf16(xcur, (bf16_t*)(ws + WS_XB), blk * 512 + tid, G * 512);
        xcd_barrier(xbar);
        PH(); if (PHM & 2048) { pg8::Gemm g{(const bf16_t*)(ws + WS_XB), (const bf16_t*)(wl + W_G), M, 3072, 1024}; pg8::StaticOrder so; so.init(M, 3072, G, blk);
          EpiGate E{q->in[3] + l * 3072, (bf16_t*)(ws + WS_GP)}; pg8::gemm_phase<EpiGate, pg8::StaticOrder, true, true>(glds, g, so, E); }
        xcd_barrier(xbar);
        PH(); if (PHM & 4096) {
            pg8::Gemm g{(const bf16_t*)(ws + WS_ZQ), (const bf16_t*)(wl + W_B), 3 * M, 3072, 512}; BrOrder so; so.so.init(M, 1024, G, blk);
            EpiP E{(const bf16_t*)(ws + WS_GP), (bf16_t*)(ws + WS_MIX)}; pg8::gemm_phase<EpiP, BrOrder, true, true>(glds, g, so, E);
        }
        xcd_barrier(xbar);
        PH(); if (PHM & 8192) { pg8::Gemm g{(const bf16_t*)(ws + WS_MIX), (const bf16_t*)(wl + W_O3), M, 1024, 1024}; pg8::StaticOrder so; so.init(M, 1024, G, blk);
          EpiOut E{xcur, q->out, (float*)(ws + WS_LNST)}; pg8::gemm_phase<EpiOut, pg8::StaticOrder, true, true>(glds, g, so, E); }
        xcd_barrier(xbar);
        PH(); if (PHM & 16384) ln_phase(q, l, l + 1 < DEPTH, lane, wave, blk, G);
        if (l + 1 < DEPTH) xcd_barrier(xbar);
}

__global__ void __launch_bounds__(512, 2) mega_fwd(Params p) {
    extern __shared__ __attribute__((aligned(16))) unsigned char smem[];
    cg::grid_group grid = cg::this_grid();
    volatile XLAS unsigned* xst = (volatile XLAS unsigned*)(smem + LDS_BYTES - 16);
    if (threadIdx.x < 4) xst[threadIdx.x] = 0u;
    __syncthreads();
    const XcdBarrier xbar = xcd_barrier_post((unsigned*)(((PP)__builtin_amdgcn_kernarg_segment_ptr())->ws + WS_BAR), xst);
    {
        int tid = threadIdx.x, lane = tid & 63, wave = __builtin_amdgcn_readfirstlane(tid >> 6);
        const int G = gridDim.x, blk = blockIdx.x;
        PP q = (PP)__builtin_amdgcn_kernarg_segment_ptr();
        unsigned char* ws = q->ws;
        PH(); if (PHM & 1) phase0(q, smem, tid, lane, wave, blk, G);
        grid.sync();
    }
    run_layer<0>(smem, xbar);
    run_layer<1>(smem, xbar);
}

extern "C" void kernel_launch(void* const* d_in, const int* in_sizes, int n_in, void* d_out, int out_size, void* d_ws, size_t ws_size, hipStream_t stream) {
    static int grid_blocks = 0;
    if (grid_blocks == 0) {
        if (n_in != 20 || out_size != M * 1024 || ws_size < WS_END) { fprintf(stderr, "kernel_launch: unexpected shapes (n_in %d out %d ws %zu)\n", n_in, out_size, ws_size); grid_blocks = -1; return; }
        int dev = 0, cus = 0, per_cu = 0;
        hipGetDevice(&dev); hipDeviceGetAttribute(&cus, hipDeviceAttributeMultiprocessorCount, dev);
        if (hipFuncSetAttribute((const void*)mega_fwd, hipFuncAttributeMaxDynamicSharedMemorySize, LDS_BYTES) != hipSuccess) { fprintf(stderr, "kernel_launch: hipFuncSetAttribute failed\n"); }
        if (hipOccupancyMaxActiveBlocksPerMultiprocessor(&per_cu, (const void*)mega_fwd, 512, LDS_BYTES) != hipSuccess || per_cu < 1) { fprintf(stderr, "kernel_launch: occupancy query says %d\n", per_cu); per_cu = 1; }
        (void)hipGetLastError();
        grid_blocks = cus;
    }
    if (grid_blocks < 0) return;
    if (hipMemsetAsync((char*)d_ws + WS_BAR, 0, XCD_BAR_WORDS * sizeof(unsigned), stream) != hipSuccess) { fprintf(stderr, "kernel_launch: hipMemsetAsync failed\n"); return; }
    Params p{};
    for (int i = 0; i < 20; ++i) p.in[i] = (const float*)d_in[i];
    p.out = (float*)d_out; p.ws = (unsigned char*)d_ws;
    void* args[] = {&p};
    hipError_t e = hipLaunchCooperativeKernel((const void*)mega_fwd, dim3(grid_blocks), dim3(512), args, LDS_BYTES, stream);
    if (e != hipSuccess) fprintf(stderr, "cooperative launch failed: %s (grid %d)\n", hipGetErrorString(e), grid_blocks);
}
```

```cpp
#include <hip/hip_runtime.h>
#include <hip/hip_cooperative_groups.h>
#include <cstdio>
#include <cstdint>
namespace cg = cooperative_groups;
namespace pg8 {
#define PG8_LAS __attribute__((address_space(3)))
typedef unsigned short bf16_t;
typedef short bf16x8 __attribute__((ext_vector_type(8)));
typedef float f32x4 __attribute__((ext_vector_type(4)));
typedef unsigned u32x4 __attribute__((ext_vector_type(4)));
constexpr int BM = 256, BK = 64, HALF = 128, HTB = HALF * BK * 2  , STAGE_BYTES = 8 * HTB, NXCD = 8, WGM = 8;

__host__ __device__ __forceinline__ int lds_byte(int r, int c) { const int st = (r >> 4) * 2 + (c >> 5), rr = r & 15, cc = c & 31, ob = rr * 64 + cc * 2; return st * 1024 + (ob ^ (((ob >> 9) & 1) << 5)); }
__host__ __device__ __forceinline__ void stage_rc(int b, int& R, int& C) { const int st = b / 1024, sb = b % 1024, swz = sb ^ (((sb >> 9) & 1) << 5); R = (st >> 1) * 16 + swz / 64; C = (st & 1) * 32 + (swz % 64) / 2; }
__host__ __device__ __forceinline__ int perm32(int rho) { const int n = rho >> 4, i = rho & 15; return 8 * (i >> 2) + 4 * n + (i & 3); }

struct Unit { int pm, pn; };
struct Gemm { const bf16_t* A; const bf16_t* Bt; int M, N, K; };

struct StaticOrder {
    int nM, nN, nwg, G, c;
    __host__ __device__ void init(int M, int N, int G_, int c_) { nM = M / BM; nN = N / BM; nwg = nM * nN; G = G_; c = c_; }
    __host__ __device__ bool next(int i, Unit& u) const {
        const long L = (long)i * G + c; if (L >= nwg) return false;
        int wgid = (int)L; { const int q = nwg / NXCD, r = nwg % NXCD, xcd = wgid % NXCD, off = wgid / NXCD; wgid = (xcd < r ? xcd * (q + 1) : r * (q + 1) + (xcd - r) * q) + off; }
        const int nig = WGM * nN, gid = wgid / nig, fm = gid * WGM, gsz = (nM - fm) < WGM ? (nM - fm) : WGM;
        u.pm = fm + ((wgid % nig) % gsz); u.pn = (wgid % nig) / gsz; return true;
    }
    __device__ __forceinline__ void a_ready(const Unit&) const {}
    __device__ __forceinline__ void done(const Unit&) const {}
};

__device__ __forceinline__ unsigned cvt_pk_bf16(float lo, float hi) { unsigned r; asm volatile("v_cvt_pk_bf16_f32 %0, %1, %2" : "=v"(r) : "v"(lo), "v"(hi)); return r; }
template <class Epi, class Sched, bool ALIGN_EPI = false, bool SP2 = false>
__device__ __forceinline__ void gemm_phase(PG8_LAS unsigned char* lds, const Gemm g, const Sched& S, const Epi& E) {
    int tid_l = threadIdx.x; asm volatile("" : "+v"(tid_l));
    const int tid = tid_l, wid = __builtin_amdgcn_readfirstlane(tid >> 6), lane = tid & 63, wr = wid >> 2, wc = wid & 3, fr = lane & 15, fq = lane >> 4;
    const int K = g.K, nt = K / BK;
    unsigned voffA[2], voffB[2];
#pragma unroll
    for (int i = 0; i < 2; ++i) { int R, C; stage_rc(tid * 16 + i * 8192, R, C); const int Rb = Epi::PERM ? ((R & ~31) + perm32(R & 31)) : R;
        voffA[i] = (unsigned)(R * K + C) * 2u; voffB[i] = (unsigned)(Rb * K + C) * 2u; }
    const size_t kstep = (size_t)(BK * 2);
    const size_t hstep = (size_t)HALF * K * 2;
    const size_t tstep = 2 * hstep;
    const unsigned ldsw = (unsigned)wid * 1024u;
    const int aoff = lds_byte(wr * 64 + fr, fq * 8), boff = lds_byte(wc * 32 + fr, fq * 8);
#define PG8_SA(b, h) (((b) * 2 + (h)) * HTB)
#define PG8_SB(b, h) ((4 + (b) * 2 + (h)) * HTB)
#define PG8_STAGE(bufoff, gbase, voff) do { _Pragma("unroll") for (int _i = 0; _i < 2; ++_i) \
        __builtin_amdgcn_global_load_lds((const unsigned*)((const char*)(gbase) + (voff)[_i]), (PG8_LAS unsigned*)(lds + (bufoff) + ldsw + _i * 8192), 16, 0, 0); } while (0)
#define PG8_LDA(dst, b, h) do { _Pragma("unroll") for (int m = 0; m < 4; ++m) _Pragma("unroll") for (int k = 0; k < 2; ++k) dst[m][k] = *(const PG8_LAS bf16x8*)(lds + PG8_SA(b, h) + aoff + m * 2048 + k * 1024); } while (0)
#define PG8_LDB(dst, b, h) do { _Pragma("unroll") for (int n = 0; n < 2; ++n) _Pragma("unroll") for (int k = 0; k < 2; ++k) dst[n][k] = *(const PG8_LAS bf16x8*)(lds + PG8_SB(b, h) + boff + n * 2048 + k * 1024); } while (0)
#define PG8_MMA(ai, bj, At, Bt) do { __builtin_amdgcn_s_setprio(1); _Pragma("unroll") for (int m = 0; m < 4; ++m) _Pragma("unroll") for (int n = 0; n < 2; ++n) _Pragma("unroll") for (int k = 0; k < 2; ++k) \
        acc[ai][bj][m][n] = __builtin_amdgcn_mfma_f32_16x16x32_bf16(Bt[n][k], At[m][k], acc[ai][bj][m][n], 0, 0, 0); __builtin_amdgcn_s_setprio(0); } while (0)
#define PG8_WAIT_V(n) asm volatile("s_waitcnt vmcnt(" #n ")" ::: "memory")
#define PG8_WAIT_L(n) asm volatile("s_waitcnt lgkmcnt(" #n ")" ::: "memory")
#define PG8_BAR __builtin_amdgcn_s_barrier()
#define PG8_SCHED __builtin_amdgcn_sched_barrier(0)
    Unit cur, nxt; int ui = 0;
    if (!S.next(0, cur)) return;
    f32x4 acc[2][2][4][2];
#pragma unroll
    for (int a = 0; a < 2; ++a)
#pragma unroll
        for (int b = 0; b < 2; ++b)
#pragma unroll
            for (int m = 0; m < 4; ++m)
#pragma unroll
                for (int n = 0; n < 2; ++n) acc[a][b][m][n] = (f32x4){0.f, 0.f, 0.f, 0.f};
    bf16x8 At[4][2], B0[2][2], B1[2][2];
    const char* cA = (const char*)g.A + (size_t)cur.pm * tstep; const char* cB = (const char*)g.Bt + (size_t)cur.pn * tstep;
    S.a_ready(cur);
    if constexpr (SP2) {
        PG8_STAGE(PG8_SB(0, 0), cB, voffB); PG8_STAGE(PG8_SB(0, 1), cB + hstep, voffB); PG8_STAGE(PG8_SA(0, 0), cA, voffA); PG8_STAGE(PG8_SA(0, 1), cA + hstep, voffA);
        if (wr == 1) PG8_BAR;
        PG8_WAIT_V(2); PG8_BAR;
        PG8_STAGE(PG8_SB(1, 0), cB + kstep, voffB); PG8_STAGE(PG8_SA(1, 0), cA + kstep, voffA); PG8_STAGE(PG8_SB(1, 1), cB + hstep + kstep, voffB);
        PG8_WAIT_V(6); PG8_BAR;
    } else {
        PG8_STAGE(PG8_SB(0, 0), cB, voffB); PG8_STAGE(PG8_SA(0, 0), cA, voffA); PG8_STAGE(PG8_SB(0, 1), cB + hstep, voffB); PG8_STAGE(PG8_SA(0, 1), cA + hstep, voffA);
        if (wr == 1) PG8_BAR;
        PG8_WAIT_V(4); PG8_BAR;
        PG8_STAGE(PG8_SB(1, 0), cB + kstep, voffB); PG8_STAGE(PG8_SA(1, 0), cA + kstep, voffA); PG8_STAGE(PG8_SB(1, 1), cB + hstep + kstep, voffB);
        PG8_WAIT_V(6); PG8_BAR;
    }
    for (;;) {
        const bool has_next = S.next(ui + 1, nxt);
        const char* nA = has_next ? (const char*)g.A + (size_t)nxt.pm * tstep : cA; const char* nB = has_next ? (const char*)g.Bt + (size_t)nxt.pn * tstep : cB;
        for (int t = 0; t < nt; t += 2) {
            const bool last = (t == nt - 2);
            const char* a1 = cA + (size_t)(t + 1) * kstep;
            const char* a2 = last ? nA : cA + (size_t)(t + 2) * kstep; const char* b2 = last ? nB : cB + (size_t)(t + 2) * kstep;
            const char* a3 = a2 + kstep; const char* b3 = b2 + kstep;
            if (last && has_next) S.a_ready(nxt);
            if constexpr (SP2) {
            PG8_LDB(B0, 0, 0); PG8_LDB(B1, 0, 1); PG8_SCHED; PG8_LDA(At, 0, 0); PG8_STAGE(PG8_SA(1, 1), a1 + hstep, voffA);
            PG8_WAIT_V(8); PG8_WAIT_L(0); PG8_BAR; PG8_MMA(0, 0, At, B0); PG8_MMA(0, 1, At, B1); PG8_BAR; PG8_SCHED;
            PG8_LDA(At, 0, 1); PG8_STAGE(PG8_SB(0, 0), b2, voffB); PG8_STAGE(PG8_SB(0, 1), b2 + hstep, voffB); PG8_STAGE(PG8_SA(0, 0), a2, voffA);
            PG8_WAIT_V(8); PG8_WAIT_L(0); PG8_BAR; PG8_MMA(1, 0, At, B0); PG8_MMA(1, 1, At, B1); PG8_BAR; PG8_SCHED;
            PG8_LDB(B0, 1, 0); PG8_LDB(B1, 1, 1); PG8_SCHED; PG8_LDA(At, 1, 0); PG8_STAGE(PG8_SA(0, 1), a2 + hstep, voffA);
            PG8_WAIT_V(8); PG8_WAIT_L(0); PG8_BAR; PG8_MMA(0, 0, At, B0); PG8_MMA(0, 1, At, B1); PG8_BAR; PG8_SCHED;
            PG8_LDA(At, 1, 1); PG8_STAGE(PG8_SB(1, 0), b3, voffB); PG8_STAGE(PG8_SB(1, 1), b3 + hstep, voffB); PG8_STAGE(PG8_SA(1, 0), a3, voffA);
            PG8_WAIT_V(8); PG8_WAIT_L(0); PG8_BAR; PG8_MMA(1, 0, At, B0); PG8_MMA(1, 1, At, B1); PG8_BAR; PG8_SCHED;
            } else {
            PG8_LDB(B0, 0, 0); PG8_SCHED; PG8_LDA(At, 0, 0); PG8_STAGE(PG8_SA(1, 1), a1 + hstep, voffA);
            PG8_WAIT_L(8); PG8_BAR; PG8_WAIT_L(0); PG8_MMA(0, 0, At, B0); PG8_BAR; PG8_SCHED;
            PG8_LDB(B1, 0, 1); PG8_STAGE(PG8_SB(0, 0), b2, voffB);
            PG8_BAR; PG8_WAIT_L(0); PG8_MMA(0, 1, At, B1); PG8_BAR;
            PG8_LDA(At, 0, 1); PG8_STAGE(PG8_SA(0, 0), a2, voffA);
            PG8_BAR; PG8_WAIT_L(0); PG8_MMA(1, 0, At, B0); PG8_BAR; PG8_SCHED;
            PG8_STAGE(PG8_SB(0, 1), b2 + hstep, voffB);
            PG8_WAIT_V(6); PG8_BAR; PG8_MMA(1, 1, At, B1); PG8_BAR;
            PG8_LDB(B0, 1, 0); PG8_SCHED; PG8_LDA(At, 1, 0); PG8_STAGE(PG8_SA(0, 1), a2 + hstep, voffA);
            PG8_WAIT_L(8); PG8_BAR; PG8_WAIT_L(0); PG8_MMA(0, 0, At, B0); PG8_BAR; PG8_SCHED;
            PG8_LDB(B1, 1, 1); PG8_STAGE(PG8_SB(1, 0), b3, voffB);
            PG8_BAR; PG8_WAIT_L(0); PG8_MMA(0, 1, At, B1); PG8_BAR;
            PG8_LDA(At, 1, 1); PG8_STAGE(PG8_SA(1, 0), a3, voffA);
            PG8_BAR; PG8_WAIT_L(0); PG8_MMA(1, 0, At, B0); PG8_BAR; PG8_SCHED;
            PG8_STAGE(PG8_SB(1, 1), b3 + hstep, voffB);
            PG8_WAIT_V(6); PG8_BAR; PG8_MMA(1, 1, At, B1); PG8_BAR;
            }
        }
        if constexpr (ALIGN_EPI) { if (wr == 0) PG8_BAR; }
        if constexpr (!Epi::AFTER_DRAIN) { E(acc, cur, wr, wc, fr, fq); S.done(cur); }
        if (!has_next) break;
#pragma unroll
        for (int a = 0; a < 2; ++a)
#pragma unroll
            for (int b = 0; b < 2; ++b)
#pragma unroll
                for (int m = 0; m < 4; ++m)
#pragma unroll
                    for (int n = 0; n < 2; ++n) acc[a][b][m][n] = (f32x4){0.f, 0.f, 0.f, 0.f};
        cur = nxt; cA = nA; cB = nB; ++ui;
        if constexpr (ALIGN_EPI) { if (wr == 1) PG8_BAR; }
    }
    PG8_WAIT_V(0);
    if constexpr (!ALIGN_EPI) { if (wr == 0) PG8_BAR; }
    PG8_BAR;
    if constexpr (Epi::AFTER_DRAIN) { E.fused(acc, cur, wr, wc, fr, fq, lds, wid, lane); S.done(cur); }
#undef PG8_SA
#undef PG8_SB
#undef PG8_STAGE
#undef PG8_LDA
#undef PG8_LDB
#undef PG8_MMA
#undef PG8_WAIT_V
#undef PG8_WAIT_L
#undef PG8_BAR
#undef PG8_SCHED
}
}
typedef unsigned short bf16_t;
typedef short bf16x8 __attribute__((ext_vector_type(8)));
typedef short s16x4 __attribute__((ext_vector_type(4)));
typedef float f32x4 __attribute__((ext_vector_type(4)));
typedef float f32x2 __attribute__((ext_vector_type(2)));
typedef float f32x16 __attribute__((ext_vector_type(16)));
typedef unsigned u32x4 __attribute__((ext_vector_type(4)));
typedef unsigned u32x2 __attribute__((ext_vector_type(2)));
#define DI __device__ __forceinline__

constexpr int NB = 4, S = 8192, M = NB * S, DEPTH = 2;
constexpr size_t MiB = (size_t)1 << 20;
constexpr size_t W_IN = 0;
constexpr size_t W_G = W_IN + (size_t)4352 * 1024 * 2;
constexpr size_t W_UQ = W_G + (size_t)3072 * 1024 * 2;
constexpr size_t W_UKV = W_UQ + (size_t)768 * 512 * 2;
constexpr size_t W_B = W_UKV + (size_t)1024 * 256 * 2;
constexpr size_t W_O3 = W_B + (size_t)3 * 1024 * 512 * 2;
constexpr size_t W_LRU = W_O3 + (size_t)1024 * 3072 * 2;
constexpr size_t W_LAYER = W_LRU + (size_t)8 * 2 * 64 * 64 * 2;
static_assert(2 * W_LAYER <= 52 * MiB, "weights");
constexpr size_t WS_W = 0;
constexpr size_t WS_SSQ = 52 * MiB;
constexpr size_t WS_SSKV = 53 * MiB;
constexpr size_t WS_LRUS = 54 * MiB;
constexpr size_t WS_LNST = 55 * MiB;
constexpr size_t WS_BAR = 59 * MiB;
constexpr size_t WS_CKV = 60 * MiB;
constexpr size_t WS_XB = 92 * MiB;
constexpr size_t WS_ZQ = 156 * MiB;
constexpr size_t WS_GLRU = 188 * MiB;
constexpr size_t WS_RQ = 220 * MiB;
constexpr size_t WS_ZKV = 252 * MiB;
constexpr size_t WS_GMLA = 268 * MiB;
constexpr size_t WS_LRUU = 300 * MiB;
constexpr size_t WS_RK = 332 * MiB;
constexpr size_t WS_RV = 364 * MiB;
constexpr size_t WS_GRET = 396 * MiB;
constexpr size_t WS_KF = 428 * MiB;
constexpr size_t WS_V = 476 * MiB;
constexpr size_t WS_GP = 252 * MiB;
constexpr size_t WS_MIX = 444 * MiB;
constexpr size_t WS_END = 508 * MiB;
constexpr int LDS_BYTES = 136 * 1024;
#ifndef PHM
#define PHM 0xFFFF
#endif
constexpr float L2_10000 = 13.287712379549449f;
constexpr float C2Q = 0.14724444602590306f;

struct Params { const float* in[20]; float* out; unsigned char* ws; };
typedef const Params __attribute__((address_space(4)))* PP;

DI float bf2f(bf16_t v) { return __uint_as_float(((unsigned)v) << 16); }
DI unsigned pk2(float lo, float hi) { typedef __bf16 b2 __attribute__((ext_vector_type(2))); f32x2 v = {lo, hi}; b2 b = __builtin_convertvector(v, b2); return __builtin_bit_cast(unsigned, b); }
DI bf16_t f2bf(float x) { return (bf16_t)(pk2(x, 0.f) & 0xffffu); }
DI float lo16(unsigned u) { return __uint_as_float(u << 16); }
DI float hi16(unsigned u) { return __uint_as_float(u & 0xffff0000u); }
DI float sigm(float x) { return __builtin_amdgcn_rcpf(1.f + __expf(-x)); }
DI void fsincos(float ang, float& s, float& c) { const float r = __builtin_amdgcn_fractf(ang * 0.15915494309189535f); s = __builtin_amdgcn_sinf(r); c = __builtin_amdgcn_cosf(r); }
DI float ex2(float x) { return __builtin_amdgcn_exp2f(x); }
DI int crow(int r, int hi) { return (r & 3) + 8 * (r >> 2) + 4 * hi; }
#define MFMA32(a, b, c) __builtin_amdgcn_mfma_f32_32x32x16_bf16((a), (b), (c), 0, 0, 0)
#define MFMA16(a, b, c) __builtin_amdgcn_mfma_f32_16x16x32_bf16((a), (b), (c), 0, 0, 0)
#define LDS_FENCE() asm volatile("s_waitcnt lgkmcnt(0)" ::: "memory")
typedef short v4i16_t __attribute__((ext_vector_type(4)));
DI s16x4 trrd(const void* p) { return __builtin_bit_cast(s16x4, __builtin_amdgcn_ds_read_tr16_b64_v4i16((__attribute__((address_space(3))) v4i16_t*)p)); }
DI bf16x8 cat8(s16x4 lo, s16x4 hi) { return __builtin_shufflevector(lo, hi, 0, 1, 2, 3, 4, 5, 6, 7); }
DI bf16x8 pack8(float a0, float a1, float a2, float a3, float a4, float a5, float a6, float a7) { u32x4 w = {pk2(a0, a1), pk2(a2, a3), pk2(a4, a5), pk2(a6, a7)}; return __builtin_bit_cast(bf16x8, w); }

DI void cvt_job(const float* __restrict__ W, int ldw, int sc0, int k0, int kvalid, bf16_t* WT, int ldd, int drow0, int dk0, const float* kscale, float* scr, int lane) {
#pragma unroll 8
    for (int i = 0; i < 32; ++i) { const int kk = 2 * i + (lane >> 5), k = k0 + kk; float v = 0.f;
        if (sc0 >= 0 && k < kvalid) { v = W[(size_t)k * ldw + sc0 + (lane & 31)]; if (kscale) v *= kscale[k]; }
        scr[kk * 33 + (lane & 31)] = v; }
    LDS_FENCE();
    const int c = lane & 7;
#pragma unroll
    for (int j = 0; j < 4; ++j) { const int n = (lane >> 3) + 8 * j; const float* s = scr + (8 * c) * 33 + n;
        u32x4 o; o.x = pk2(s[0 * 33], s[1 * 33]); o.y = pk2(s[2 * 33], s[3 * 33]); o.z = pk2(s[4 * 33], s[5 * 33]); o.w = pk2(s[6 * 33], s[7 * 33]);
        *(u32x4*)(WT + (size_t)(drow0 + n) * ldd + dk0 + 8 * c) = o; }
    LDS_FENCE();
}
DI void cvt_rows_bf16(const float* __restrict__ src, bf16_t* dst, int gtid, int nthr) {
    const size_t n8 = (size_t)M * 1024 / 8;
    for (size_t i = gtid; i < n8; i += nthr) { const f32x4 a = ((const f32x4*)src)[2 * i], b = ((const f32x4*)src)[2 * i + 1];
        u32x4 o = {pk2(a.x, a.y), pk2(a.z, a.w), pk2(b.x, b.y), pk2(b.z, b.w)}; ((u32x4*)dst)[i] = o; }
}
DI void phase0(PP p, unsigned char* smem, int tid, int lane, int wave, int blk, int G) {
    float* scr = (float*)(smem + wave * 8448);
    const int gw = blk * 8 + wave, NGW = G * 8;
    constexpr int J1 = 136 * 16, J2 = 96 * 16, J3 = 24 * 8, J4 = 32 * 4, J5 = 3 * 32 * 8, J6 = 32 * 16, J7 = 32, JL = J1 + J2 + J3 + J4 + J5 + J6 + J7;
    for (int it = gw; it < DEPTH * JL; it += NGW) {
        const int l = it / JL; int r = it % JL;
        unsigned char* wl = p->ws + WS_W + (size_t)l * W_LAYER;
        const float* win = p->in[2] + (size_t)l * 1024 * 7328;
        if (r < J1) { const int g = r >> 4, kt = r & 15; int sc; if (g < 12) sc = 32 * g; else if (g == 12) sc = 640; else if (g < 16) sc = -1; else if (g < 24) sc = 384 + 32 * (g - 16); else sc = 672 + 32 * (g - 24);
            cvt_job(win, 7328, sc, 64 * kt, 1024, (bf16_t*)(wl + W_IN), 1024, 32 * g, 64 * kt, nullptr, scr, lane); continue; }
        r -= J1;
        if (r < J2) { const int g = r >> 4, kt = r & 15; cvt_job(win, 7328, 4256 + 32 * g, 64 * kt, 1024, (bf16_t*)(wl + W_G), 1024, 32 * g, 64 * kt, nullptr, scr, lane); continue; }
        r -= J2;
        if (r < J3) { const int g = r >> 3, kt = r & 7; cvt_job(p->in[5] + (size_t)l * 384 * 768, 768, 32 * g, 64 * kt, 384, (bf16_t*)(wl + W_UQ), 512, 32 * g, 64 * kt, p->in[4] + l * 384, scr, lane); continue; }
        r -= J3;
        if (r < J4) { const int g = r >> 2, kt = r & 3; const int gg = g & 15, h = gg >> 1, d0 = (gg & 1) * 32; const int sc = h * 128 + d0 + (g >= 16 ? 64 : 0);
            cvt_job(p->in[7] + (size_t)l * 256 * 1024, 1024, sc, 64 * kt, 256, (bf16_t*)(wl + W_UKV), 256, 32 * g, 64 * kt, p->in[6] + l * 256, scr, lane); continue; }
        r -= J4;
        if (r < J5) { const int br = r / 256, rr = r % 256, g = rr >> 3, kt = rr & 7;
            cvt_job(p->in[16] + (size_t)(l * 3 + br) * 512 * 1024, 1024, 32 * g, 64 * kt, 512, (bf16_t*)(wl + W_B) + (size_t)br * 1024 * 512, 512, 32 * g, 64 * kt, nullptr, scr, lane); continue; }
        r -= J5;
        if (r < J6) { const int g = r >> 4, kt = r & 15;
            cvt_job(p->in[17] + (size_t)l * 1024 * 1024, 1024, 32 * g, 64 * kt, 1024, (bf16_t*)(wl + W_O3), 1024, 32 * g, 64 * kt, nullptr, scr, lane); continue; }
        r -= J6;
        { const int h = r >> 2, gate = (r >> 1) & 1, grp = r & 1; const float* src = (gate ? p->in[12] : p->in[10]) + (size_t)(l * 8 + h) * 4096;
            cvt_job(src, 64, 32 * grp, 0, 64, (bf16_t*)(wl + W_LRU), 64, (h * 2 + gate) * 64 + 32 * grp, 0, nullptr, scr, lane); }
    }
    cvt_rows_bf16(p->in[0], (bf16_t*)(p->ws + WS_XB), blk * 512 + tid, G * 512);
}

typedef const pg8::f32x4 (&AccRef)[2][2][4][2];
struct EpiZ {
    static constexpr bool PERM = true, AFTER_DRAIN = false;
    unsigned char* ws;
    DI void operator()(AccRef acc, const pg8::Unit& u, int wr, int wc, int fr, int fq) const {
        asm volatile("" : "+v"(fr), "+v"(fq));
        const int pn = u.pn; size_t boff; int pitch, coff;
        if (pn < 2) { boff = WS_ZQ; pitch = 512; coff = 256 * pn; }
        else if (pn == 2) { boff = WS_ZKV; pitch = 256; coff = 0; }
        else { const int s = (pn - 3) >> 1; coff = 256 * ((pn - 3) & 1); pitch = 512;
            boff = s == 0 ? WS_GMLA : s == 1 ? WS_LRUU : s == 2 ? WS_GLRU : s == 3 ? WS_RQ : s == 4 ? WS_RK : s == 5 ? WS_RV : WS_GRET; }
        bf16_t* base = (bf16_t*)(ws + boff);
        float* ssq = (float*)(ws + WS_SSQ); float* sskv = (float*)(ws + WS_SSKV);
        const int row0 = u.pm * 256 + wr * 64 + fr, col0 = coff + wc * 32 + 8 * fq;
#pragma unroll
        for (int ai = 0; ai < 2; ++ai)
#pragma unroll
            for (int m = 0; m < 4; ++m) { const int row = row0 + ai * 128 + m * 16; bf16_t* rowp = base + (size_t)row * pitch + col0; float ss = 0.f;
#pragma unroll
                for (int bj = 0; bj < 2; ++bj) { const pg8::f32x4 v0 = acc[ai][bj][m][0], v1 = acc[ai][bj][m][1];
                    u32x4 w = {pk2(v0[0], v0[1]), pk2(v0[2], v0[3]), pk2(v1[0], v1[1]), pk2(v1[2], v1[3])}; *(u32x4*)(rowp + bj * 128) = w;
                    if (pn != 1 || bj == 0) ss += (v0[0] * v0[0] + v0[1] * v0[1]) + (v0[2] * v0[2] + v0[3] * v0[3]) + (v1[0] * v1[0] + v1[1] * v1[1]) + (v1[2] * v1[2] + v1[3] * v1[3]); }
                if (pn <= 2) { ss += __shfl_xor(ss, 16); ss += __shfl_xor(ss, 32);
                    if (fq == 0) { if (pn < 2) ssq[(size_t)row * 8 + pn * 4 + wc] = ss; else sskv[(size_t)row * 4 + wc] = ss; } } }
    }
};
struct EpiQ {
    static constexpr bool PERM = false, AFTER_DRAIN = false;
    const float* ssq; const int* pos; bf16_t* Q;
    DI void operator()(AccRef acc, const pg8::Unit& u, int wr, int wc, int fr, int fq) const {
        asm volatile("" : "+v"(fr), "+v"(fq));
        float invf[4];
#pragma unroll
        for (int e = 0; e < 4; ++e) invf[e] = ex2(-(float)(4 * fq + e) * (L2_10000 / 16.f));
        const int g0 = (u.pn * 256 + wc * 32) >> 5; const bool rope0 = (g0 % 3) == 2, rope1 = ((g0 + 4) % 3) == 2;
        const int row0 = u.pm * 256 + wr * 64 + fr, col0 = u.pn * 256 + wc * 32 + 4 * fq;
#pragma unroll
        for (int ai = 0; ai < 2; ++ai)
#pragma unroll
            for (int m = 0; m < 4; ++m) { const int row = row0 + ai * 128 + m * 16;
                const f32x4 s0 = *(const f32x4*)(ssq + (size_t)row * 8), s1 = *(const f32x4*)(ssq + (size_t)row * 8 + 4);
                const float ss = ((s0.x + s0.y) + (s0.z + s0.w)) + ((s1.x + s1.y) + (s1.z + s1.w));
                const float rs = rsqrtf(ss * (1.f / 384.f) + 1e-6f) * C2Q;
                float cs[4] = {1.f, 1.f, 1.f, 1.f}, sn[4] = {0.f, 0.f, 0.f, 0.f};
                if (rope0 || rope1) { const float pf = (float)pos[row];
#pragma unroll
                    for (int e = 0; e < 4; ++e) fsincos(pf * invf[e], sn[e], cs[e]); }
#pragma unroll
                for (int bj = 0; bj < 2; ++bj) { pg8::f32x4 v0 = acc[ai][bj][m][0] * rs, v1 = acc[ai][bj][m][1] * rs;
                    if (bj ? rope1 : rope0) {
#pragma unroll
                        for (int e = 0; e < 4; ++e) { const float x1 = v0[e], x2 = v1[e]; v0[e] = x1 * cs[e] - x2 * sn[e]; v1[e] = x2 * cs[e] + x1 * sn[e]; } }
                    bf16_t* dst = Q + (size_t)row * 768 + col0 + bj * 128;
                    u32x2 w0 = {pk2(v0[0], v0[1]), pk2(v0[2], v0[3])}, w1 = {pk2(v1[0], v1[1]), pk2(v1[2], v1[3])};
                    *(u32x2*)dst = w0; *(u32x2*)(dst + 16) = w1; } }
    }
};
struct EpiKV {
    static constexpr bool PERM = true, AFTER_DRAIN = false;
    const float* sskv; bf16_t* KF; bf16_t* V;
    DI void operator()(AccRef acc, const pg8::Unit& u, int wr, int wc, int fr, int fq) const {
        asm volatile("" : "+v"(fr), "+v"(fq));
        const int row0 = u.pm * 256 + wr * 64 + fr;
        const bool isk = u.pn < 2; bf16_t* base = isk ? KF : V; const int pitch = isk ? 768 : 512;
        const int c0 = u.pn * 256 + wc * 32 + 8 * fq, c1 = c0 + 128;
        const int o0 = isk ? (c0 >> 6) * 96 + (c0 & 63) : c0 - 512, o1 = isk ? (c1 >> 6) * 96 + (c1 & 63) : c1 - 512;
#pragma unroll
        for (int ai = 0; ai < 2; ++ai)
#pragma unroll
            for (int m = 0; m < 4; ++m) { const int row = row0 + ai * 128 + m * 16;
                const f32x4 s0 = *(const f32x4*)(sskv + (size_t)row * 4);
                const float rs = rsqrtf(((s0.x + s0.y) + (s0.z + s0.w)) * (1.f / 256.f) + 1e-6f);
                bf16_t* rowp = base + (size_t)row * pitch;
#pragma unroll
                for (int bj = 0; bj < 2; ++bj) { const pg8::f32x4 v0 = acc[ai][bj][m][0] * rs, v1 = acc[ai][bj][m][1] * rs;
                    u32x4 w = {pk2(v0[0], v0[1]), pk2(v0[2], v0[3]), pk2(v1[0], v1[1]), pk2(v1[2], v1[3])};
                    *(u32x4*)(rowp + (bj ? o1 : o0)) = w; } }
    }
};
struct EpiGate {
    static constexpr bool PERM = true, AFTER_DRAIN = false;
    const float* bias; bf16_t* GP;
    DI void operator()(AccRef acc, const pg8::Unit& u, int wr, int wc, int fr, int fq) const {
        asm volatile("" : "+v"(fr), "+v"(fq));
        const int row0 = u.pm * 256 + wr * 64 + fr, col0 = u.pn * 256 + wc * 32 + 8 * fq;
        f32x4 bv[2][2];
#pragma unroll
        for (int bj = 0; bj < 2; ++bj)
#pragma unroll
            for (int n = 0; n < 2; ++n) bv[bj][n] = *(const f32x4*)(bias + col0 + bj * 128 + 4 * n);
#pragma unroll
        for (int ai = 0; ai < 2; ++ai)
#pragma unroll
            for (int m = 0; m < 4; ++m) { const int row = row0 + ai * 128 + m * 16;
#pragma unroll
                for (int bj = 0; bj < 2; ++bj) { pg8::f32x4 v0 = acc[ai][bj][m][0] + bv[bj][0], v1 = acc[ai][bj][m][1] + bv[bj][1];
#pragma unroll
                    for (int e = 0; e < 4; ++e) { v0[e] = sigm(v0[e]); v1[e] = sigm(v1[e]); }
                    u32x4 w = {pk2(v0[0], v0[1]), pk2(v0[2], v0[3]), pk2(v1[0], v1[1]), pk2(v1[2], v1[3])};
                    *(u32x4*)(GP + (size_t)row * 3072 + col0 + bj * 128) = w; } }
    }
};
struct EpiP {
    static constexpr bool PERM = true, AFTER_DRAIN = false;
    const bf16_t* GP; bf16_t* MIX; int br;
    DI void operator()(AccRef acc, const pg8::Unit& u, int wr, int wc, int fr, int fq) const {
        asm volatile("" : "+v"(fr), "+v"(fq));
        const int row0 = u.pm * 256 + wr * 64 + fr, col0 = u.pn * 256 + wc * 32 + 8 * fq;
#pragma unroll
        for (int ai = 0; ai < 2; ++ai)
#pragma unroll
            for (int m = 0; m < 4; ++m) { const int row = row0 + ai * 128 + m * 16;
#pragma unroll
                for (int bj = 0; bj < 2; ++bj) { const pg8::f32x4 v0 = acc[ai][bj][m][0], v1 = acc[ai][bj][m][1];
                    const u32x4 g = *(const u32x4*)(GP + (size_t)row * 3072 + br * 1024 + col0 + bj * 128);
                    float o[8] = {v0[0] * lo16(g.x), v0[1] * hi16(g.x), v0[2] * lo16(g.y), v0[3] * hi16(g.y), v1[0] * lo16(g.z), v1[1] * hi16(g.z), v1[2] * lo16(g.w), v1[3] * hi16(g.w)};
                    u32x4* mp = (u32x4*)(MIX + (size_t)row * 1024 + col0 + bj * 128);
                    if (br != 0) { const u32x4 mv = *mp; o[0] += lo16(mv.x); o[1] += hi16(mv.x); o[2] += lo16(mv.y); o[3] += hi16(mv.y); o[4] += lo16(mv.z); o[5] += hi16(mv.z); o[6] += lo16(mv.w); o[7] += hi16(mv.w); }
                    u32x4 w = {pk2(o[0], o[1]), pk2(o[2], o[3]), pk2(o[4], o[5]), pk2(o[6], o[7])};
                    *mp = w; } }
    }
};
struct EpiOut {
    static constexpr bool PERM = false, AFTER_DRAIN = false;
    const float* xin; float* out; float* lnst;
    DI void operator()(AccRef acc, const pg8::Unit& u, int wr, int wc, int fr, int fq) const {
        asm volatile("" : "+v"(fr), "+v"(fq));
        const int row0 = u.pm * 256 + wr * 64 + fr, col0 = u.pn * 256 + wc * 32 + 4 * fq;
#pragma unroll
        for (int ai = 0; ai < 2; ++ai)
#pragma unroll
            for (int m = 0; m < 4; ++m) { const int row = row0 + ai * 128 + m * 16; float s1 = 0.f, s2 = 0.f;
#pragma unroll
                for (int bj = 0; bj < 2; ++bj)
#pragma unroll
                    for (int n = 0; n < 2; ++n) { const size_t o = (size_t)row * 1024 + col0 + bj * 128 + n * 16;
                        const f32x4 xv = *(const f32x4*)(xin + o); f32x4 t;
#pragma unroll
                        for (int e = 0; e < 4; ++e) { t[e] = 1.4142135623730951f * xv[e] + acc[ai][bj][m][n][e]; s1 += t[e]; s2 += t[e] * t[e]; }
                        *(f32x4*)(out + o) = t; }
                s1 += __shfl_xor(s1, 16); s1 += __shfl_xor(s1, 32); s2 += __shfl_xor(s2, 16); s2 += __shfl_xor(s2, 32);
                if (fq == 0) { f32x2 v = {s1, s2}; *(f32x2*)(lnst + ((size_t)row * 16 + u.pn * 4 + wc) * 2) = v; } }
    }
};

DI void krot_phase(PP p, int gtid, int nthr) {
    const bf16_t* zq = (const bf16_t*)(p->ws + WS_ZQ); bf16_t* KF = (bf16_t*)(p->ws + WS_KF); const int* pos = (const int*)p->in[1];
    for (int idx = gtid; idx < M * 16; idx += nthr) { const int row = idx >> 4, j = idx & 15;
        const float x1 = bf2f(zq[(size_t)row * 512 + 384 + j]), x2 = bf2f(zq[(size_t)row * 512 + 400 + j]);
        float s_, c_; fsincos((float)pos[row] * ex2(-(float)j * (L2_10000 / 16.f)), s_, c_);
        const bf16_t o1 = f2bf(x1 * c_ - x2 * s_), o2 = f2bf(x2 * c_ + x1 * s_);
        bf16_t* d = KF + (size_t)row * 768 + 64 + j;
#pragma unroll
        for (int h = 0; h < 8; ++h) { d[h * 96] = o1; d[h * 96 + 16] = o2; } }
}

template <bool PASS2> DI void lru_pass(PP p, int l, unsigned char* smem, int tid, int lane, int wave, int blk, int G) {
    bf16_t* u_img = (bf16_t*)smem;
    bf16_t* xc_img = (bf16_t*)(smem + 19456);
    float* a_img = (float*)(smem + 19456 + 16640);
    float* b_img = a_img + 16 * 512;
    const bf16_t* U = (const bf16_t*)(p->ws + WS_LRUU); bf16_t* GY = (bf16_t*)(p->ws + WS_GLRU);
    const bf16_t* LW = (const bf16_t*)(p->ws + WS_W + (size_t)l * W_LAYER + W_LRU);
    float* SUM = (float*)(p->ws + WS_LRUS);
    const int c = tid;
    const float* cw = p->in[8] + (size_t)l * 4 * 512;
    const float cw0 = cw[c], cw1 = cw[512 + c], cw2 = cw[1024 + c], cw3 = cw[1536 + c], cb = p->in[9][l * 512 + c];
    float brv[4], biv[4], spv[4];
#pragma unroll
    for (int nt = 0; nt < 4; ++nt) { const int ch = 64 * wave + 16 * nt + (lane & 15); brv[nt] = p->in[11][l * 512 + ch]; biv[nt] = p->in[13][l * 512 + ch]; spv[nt] = 8.f * log1pf(expf(-p->in[14][l * 512 + ch])); }
    bf16x8 wrf[4][2], wif[4][2];
#pragma unroll
    for (int nt = 0; nt < 4; ++nt) {
        const bf16_t* wr_ = LW + (size_t)((wave * 2 + 0) * 64 + 16 * nt + (lane & 15)) * 64 + 8 * (lane >> 4);
        const bf16_t* wi_ = LW + (size_t)((wave * 2 + 1) * 64 + 16 * nt + (lane & 15)) * 64 + 8 * (lane >> 4);
        wrf[nt][0] = *(const bf16x8*)wr_; wrf[nt][1] = *(const bf16x8*)(wr_ + 32); wif[nt][0] = *(const bf16x8*)wi_; wif[nt][1] = *(const bf16x8*)(wi_ + 32); }
    for (int sc = blk; sc < 256; sc += G) {
        const int b = sc >> 6, n = sc & 63; const size_t row0 = (size_t)b * S + n * 128;
        float h = 0.f, Ap = 1.f;
        if (PASS2) { for (int m = 0; m < n; ++m) { const f32x2 ab = *(const f32x2*)(SUM + ((size_t)(b * 64 + m) * 512 + c) * 2); h = ab.x * h + ab.y; } }
        u32x4 ureg[3];
#define LRU_ULOAD(T0) do { _Pragma("unroll") for (int k_ = 0; k_ < 3; ++k_) { const int i_ = tid + 512 * k_; const int r_ = i_ >> 6, cc_ = i_ & 63; const long grow_ = (long)(T0) - 3 + r_; u32x4 v_ = {0u, 0u, 0u, 0u}; \
            if (i_ < 19 * 64 && grow_ >= (long)b * S) v_ = *(const u32x4*)(U + (size_t)grow_ * 512 + cc_ * 8); ureg[k_] = v_; } } while (0)
        LRU_ULOAD(row0);
        for (int sub = 0; sub < 8; ++sub) {
            const size_t t0 = row0 + sub * 16;
#pragma unroll
            for (int k_ = 0; k_ < 3; ++k_) { const int i_ = tid + 512 * k_; if (i_ < 19 * 64) *(u32x4*)(u_img + (i_ >> 6) * 512 + (i_ & 63) * 8) = ureg[k_]; }
            __syncthreads();
            if (sub < 7) LRU_ULOAD(t0 + 16);
#pragma unroll
            for (int t = 0; t < 16; ++t) { const float xc = cb + cw0 * bf2f(u_img[t * 512 + c]) + cw1 * bf2f(u_img[(t + 1) * 512 + c]) + cw2 * bf2f(u_img[(t + 2) * 512 + c]) + cw3 * bf2f(u_img[(t + 3) * 512 + c]);
                xc_img[t * 520 + c] = f2bf(xc); }
            __syncthreads();
            {
                const bf16_t* ap = xc_img + (lane & 15) * 520 + 64 * wave + 8 * (lane >> 4);
                const bf16x8 a0 = *(const bf16x8*)ap, a1 = *(const bf16x8*)(ap + 32);
#pragma unroll
                for (int nt = 0; nt < 4; ++nt) {
                    f32x4 ar = {0.f, 0.f, 0.f, 0.f}, ai = {0.f, 0.f, 0.f, 0.f};
                    ar = MFMA16(a0, wrf[nt][0], ar); ar = MFMA16(a1, wrf[nt][1], ar);
                    ai = MFMA16(a0, wif[nt][0], ai); ai = MFMA16(a1, wif[nt][1], ai);
                    const int ch = 64 * wave + 16 * nt + (lane & 15);
#pragma unroll
                    for (int j = 0; j < 4; ++j) { const int tok = 4 * (lane >> 4) + j;
                        const float r = sigm(ar[j] + brv[nt]), gi = sigm(ai[j] + biv[nt]);
                        const float la = -r * spv[nt]; const float a = __expf(la); const float x2 = 2.f * la;
                        const float em = x2 < -0.5f ? 1.f - __expf(x2) : -x2 * (1.f + x2 * (0.5f + x2 * ((1.f / 6.f) + x2 * ((1.f / 24.f) + x2 * (1.f / 120.f)))));
                        const float mult = __builtin_amdgcn_sqrtf(em);
                        const float xcv = bf2f(xc_img[tok * 520 + ch]);
                        a_img[tok * 512 + ch] = a; b_img[tok * 512 + ch] = mult * gi * xcv; }
                }
            }
            __syncthreads();
#pragma unroll
            for (int t = 0; t < 16; ++t) { const float a = a_img[t * 512 + c], bb = b_img[t * 512 + c]; h = a * h + bb;
                if (!PASS2) Ap *= a;
                else { const size_t o = (t0 + t) * 512 + c; const float g = bf2f(GY[o]); GY[o] = f2bf(h * g * sigm(g)); } }
        }
        if (!PASS2) { f32x2 v = {Ap, h}; *(f32x2*)(SUM + ((size_t)sc * 512 + c) * 2) = v; }
        __syncthreads();
    }
}

DI void unpack8(u32x4 v, float (&f)[8]) { f[0] = lo16(v.x); f[1] = hi16(v.x); f[2] = lo16(v.y); f[3] = hi16(v.y); f[4] = lo16(v.z); f[5] = hi16(v.z); f[6] = lo16(v.w); f[7] = hi16(v.w); }
DI u32x4 packv8(const float (&f)[8]) { u32x4 w = {pk2(f[0], f[1]), pk2(f[2], f[3]), pk2(f[4], f[5]), pk2(f[6], f[7])}; return w; }
DI void ret_pass1(PP p, unsigned char* smem, int lane, int wave, int blk, int G) {
    bf16_t* Kimg = (bf16_t*)(smem + wave * 12288); bf16_t* Vimg = Kimg + 32 * 96;
    bf16_t* RQ = (bf16_t*)(p->ws + WS_RQ); bf16_t* RK = (bf16_t*)(p->ws + WS_RK); const bf16_t* RV = (const bf16_t*)(p->ws + WS_RV);
    float* CKV = (float*)(p->ws + WS_CKV); const int* pos = (const int*)p->in[1];
    const int r32 = lane & 31, hi = lane >> 5, q4 = (lane & 15) >> 2, pp = lane & 3, blk16 = (lane >> 4) & 1;
    for (int u = blk * 8 + wave; u < 2048; u += G * 8) {
        const int h = u & 7, n = (u >> 3) & 63, b = u >> 9;
        const float l2g = log2f(1.f - exp2f(-5.f - (float)h));
        const size_t rowbase = (size_t)b * S + n * 128;
        f32x16 acc[2][2];
#pragma unroll
        for (int i = 0; i < 2; ++i)
#pragma unroll
            for (int j = 0; j < 2; ++j)
#pragma unroll
                for (int r = 0; r < 16; ++r) acc[i][j][r] = 0.f;
        for (int st = 0; st < 4; ++st) {
#pragma unroll
            for (int it = 0; it < 2; ++it) {
                const int item = it * 64 + lane, tl = item >> 2, g = item & 3, d0 = 8 * g; const int tok = 32 * st + tl;
                const size_t row = rowbase + tok, off = row * 512 + 64 * h + d0;
                float q1[8], q2[8], k1[8], k2[8];
                unpack8(*(const u32x4*)(RQ + off), q1); unpack8(*(const u32x4*)(RQ + off + 32), q2);
                unpack8(*(const u32x4*)(RK + off), k1); unpack8(*(const u32x4*)(RK + off + 32), k2);
                const u32x4 v1 = *(const u32x4*)(RV + off), v2 = *(const u32x4*)(RV + off + 32);
                const float pf = (float)pos[row]; const float kw = ex2((float)(127 - tok) * l2g);
                float kw1[8], kw2[8];
#pragma unroll
                for (int jj = 0; jj < 8; ++jj) { float s_, c_; fsincos(pf * ex2(-(float)(d0 + jj) * (L2_10000 / 32.f)), s_, c_);
                    const float a = q1[jj], bq = q2[jj]; q1[jj] = a * c_ - bq * s_; q2[jj] = bq * c_ + a * s_;
                    const float ck = k1[jj], dk = k2[jj]; k1[jj] = (ck * c_ - dk * s_) * 0.125f; k2[jj] = (dk * c_ + ck * s_) * 0.125f;
                    kw1[jj] = k1[jj] * kw; kw2[jj] = k2[jj] * kw; }
                *(u32x4*)(RQ + off) = packv8(q1); *(u32x4*)(RQ + off + 32) = packv8(q2);
                *(u32x4*)(RK + off) = packv8(k1); *(u32x4*)(RK + off + 32) = packv8(k2);
                *(u32x4*)(Kimg + tl * 96 + d0) = packv8(kw1); *(u32x4*)(Kimg + tl * 96 + d0 + 32) = packv8(kw2);
                *(u32x4*)(Vimg + tl * 96 + d0) = v1; *(u32x4*)(Vimg + tl * 96 + d0 + 32) = v2;
            }
            LDS_FENCE();
#pragma unroll
            for (int ks = 0; ks < 2; ++ks) {
                const int rowk = 16 * ks + 8 * hi;
                bf16x8 af[2], bfr[2];
#pragma unroll
                for (int x = 0; x < 2; ++x) { const int co = 32 * x + 16 * blk16 + 4 * pp;
                    af[x] = cat8(trrd(Kimg + (rowk + q4) * 96 + co), trrd(Kimg + (rowk + 4 + q4) * 96 + co));
                    bfr[x] = cat8(trrd(Vimg + (rowk + q4) * 96 + co), trrd(Vimg + (rowk + 4 + q4) * 96 + co)); }
#pragma unroll
                for (int dh = 0; dh < 2; ++dh)
#pragma unroll
                    for (int eh = 0; eh < 2; ++eh) acc[dh][eh] = MFMA32(af[dh], bfr[eh], acc[dh][eh]);
            }
            LDS_FENCE();
        }
        float* dst = CKV + ((size_t)(b * 64 + n) * 8 + h) * 4096;
#pragma unroll
        for (int dh = 0; dh < 2; ++dh)
#pragma unroll
            for (int eh = 0; eh < 2; ++eh)
#pragma unroll
                for (int r = 0; r < 16; ++r) dst[(32 * dh + crow(r, hi)) * 64 + 32 * eh + r32] = acc[dh][eh][r];
    }
}
DI void ret_prefix(PP p, int gtid, int nthr) {
    float* CKV = (float*)(p->ws + WS_CKV);
    for (int idx = gtid; idx < NB * 8 * 4096; idx += nthr) { const int de = idx & 4095, h = (idx >> 12) & 7, b = idx >> 15;
        const float decay = exp2f(128.f * log2f(1.f - exp2f(-5.f - (float)h)));
        float* base = CKV + ((size_t)b * 64 * 8 + h) * 4096 + de; float s = 0.f;
        for (int n0 = 0; n0 < 64; n0 += 8) { float t[8];
#pragma unroll
            for (int i = 0; i < 8; ++i) t[i] = base[(size_t)(n0 + i) * 8 * 4096];
#pragma unroll
            for (int i = 0; i < 8; ++i) { base[(size_t)(n0 + i) * 8 * 4096] = s; s = decay * s + t[i]; } } }
}

DI void attn_step64(const unsigned char* Kb, const unsigned char* Vb, const bf16x8 (&qf)[6], f32x16& o0, f32x16& o1, float& mrun, float& lsum, int k0, int q, bool masked, int r32, int hi, int q4, int pp, int blk16) {
    f32x16 p0, p1;
#pragma unroll
    for (int i = 0; i < 16; ++i) { p0[i] = 0.f; p1[i] = 0.f; }
#pragma unroll
    for (int d0 = 0; d0 < 6; ++d0) { const bf16x8 ka = *(const bf16x8*)(Kb + r32 * 208 + (16 * d0 + 8 * hi) * 2), kb = *(const bf16x8*)(Kb + (32 + r32) * 208 + (16 * d0 + 8 * hi) * 2);
        p0 = MFMA32(ka, qf[d0], p0); p1 = MFMA32(kb, qf[d0], p1); }
    if (masked) {
#pragma unroll
        for (int i = 0; i < 16; ++i) { const int key = k0 + crow(i, hi); if (key > q) p0[i] = -INFINITY; if (key + 32 > q) p1[i] = -INFINITY; } }
    float mx = fmaxf(p0[0], p1[0]);
#pragma unroll
    for (int i = 1; i < 16; ++i) mx = fmaxf(mx, fmaxf(p0[i], p1[i]));
    mx = fmaxf(mx, __shfl_xor(mx, 32));
    const float mn = fmaxf(mrun, mx); const float alpha = ex2(mrun - mn); mrun = mn;
    float ps = 0.f;
#pragma unroll
    for (int i = 0; i < 16; ++i) { p0[i] = ex2(p0[i] - mn); p1[i] = ex2(p1[i] - mn); ps += p0[i] + p1[i]; }
    lsum = lsum * alpha + ps;
#pragma unroll
    for (int i = 0; i < 16; ++i) { o0[i] *= alpha; o1[i] *= alpha; }
#pragma unroll
    for (int s = 0; s < 4; ++s) {
        bf16x8 pb;
        if (s == 0) pb = pack8(p0[0], p0[1], p0[2], p0[3], p0[4], p0[5], p0[6], p0[7]);
        else if (s == 1) pb = pack8(p0[8], p0[9], p0[10], p0[11], p0[12], p0[13], p0[14], p0[15]);
        else if (s == 2) pb = pack8(p1[0], p1[1], p1[2], p1[3], p1[4], p1[5], p1[6], p1[7]);
        else pb = pack8(p1[8], p1[9], p1[10], p1[11], p1[12], p1[13], p1[14], p1[15]);
        const int rowk = 16 * s + 4 * hi; const int co = (16 * blk16 + 4 * pp) * 2;
        const bf16x8 va0 = cat8(trrd(Vb + (rowk + q4) * 192 + co), trrd(Vb + (rowk + 8 + q4) * 192 + co));
        const bf16x8 va1 = cat8(trrd(Vb + (rowk + q4) * 192 + 64 + co), trrd(Vb + (rowk + 8 + q4) * 192 + 64 + co));
        o0 = MFMA32(va0, pb, o0); o1 = MFMA32(va1, pb, o1);
    }
}
#ifndef ATTN_SB
#define ATTN_SB() ((void)0)
#endif
#define PK8(P, B) pack8(P[B], P[B + 1], P[B + 2], P[B + 3], P[B + 4], P[B + 5], P[B + 6], P[B + 7])
DI void attn_phase(PP p, unsigned char* smem, int tid, int lane, int wave, int blk, int G) {
    const bf16_t* Q = (const bf16_t*)(p->ws + WS_XB); const bf16_t* KF = (const bf16_t*)(p->ws + WS_KF); const bf16_t* V = (const bf16_t*)(p->ws + WS_V);
    const bf16_t* GM = (const bf16_t*)(p->ws + WS_GMLA); bf16_t* Y = (bf16_t*)(p->ws + WS_ZQ);
    const int r32 = lane & 31, hi = lane >> 5, q4 = (lane & 15) >> 2, pp = lane & 3, blk16 = (lane >> 4) & 1;
    constexpr int KBUF = 128 * 208, VBUF = 128 * 192, VOFF = 2 * KBUF;
    int kro[3], klo[3];
#pragma unroll
    for (int i = 0; i < 3; ++i) { const int c = tid + 512 * i; kro[i] = (c / 12) * 768 + (c % 12) * 8; klo[i] = (c / 12) * 208 + (c % 12) * 16; }
    int vro[2], vlo[2];
#pragma unroll
    for (int i = 0; i < 2; ++i) { const int c = tid + 512 * i; vro[i] = (c >> 3) * 512 + (c & 7) * 8; vlo[i] = (c >> 3) * 192 + (c & 7) * 16; }
    for (int u = blk; u < 1024; u += G) {
        const int r = u & 255, i4 = u >> 8; const int bh = (r & 7) * 4 + ((r >> 3) >> 3), jj = (r >> 3) & 7;
        const int qb = i4 == 0 ? 31 - jj : i4 == 1 ? 16 + jj : i4 == 2 ? 15 - jj : jj;
        const int b = bh >> 3, h = bh & 7;
        const size_t rowb = (size_t)b * S; const int q0 = qb * 256, qw0 = q0 + wave * 32; const int NT = 2 * qb + 2;
        bf16x8 qf[6];
#pragma unroll
        for (int d0 = 0; d0 < 6; ++d0) qf[d0] = *(const bf16x8*)(Q + (rowb + qw0 + r32) * 768 + h * 96 + 16 * d0 + 8 * hi);
        f32x16 o0, o1;
#pragma unroll
        for (int i = 0; i < 16; ++i) { o0[i] = 0.f; o1[i] = 0.f; }
        float mrun = -INFINITY, lsum = 0.f;
        const bf16_t* kbase = KF + rowb * 768 + h * 96; const bf16_t* vbase = V + rowb * 512 + h * 64;
        u32x4 kg[3], vg[2];
#pragma unroll
        for (int i = 0; i < 3; ++i) kg[i] = *(const u32x4*)(kbase + kro[i]);
#pragma unroll
        for (int i = 0; i < 2; ++i) vg[i] = *(const u32x4*)(vbase + vro[i]);
#pragma unroll
        for (int i = 0; i < 3; ++i) *(u32x4*)(smem + klo[i]) = kg[i];
#pragma unroll
        for (int i = 0; i < 2; ++i) *(u32x4*)(smem + VOFF + vlo[i]) = vg[i];
        __syncthreads();
        for (int kt = 0; kt < NT; ++kt) {
            const int cur = kt & 1; const bool more = kt + 1 < NT;
            if (more) { const bf16_t* kn = kbase + (size_t)(kt + 1) * 128 * 768; const bf16_t* vn = vbase + (size_t)(kt + 1) * 128 * 512;
#pragma unroll
                for (int i = 0; i < 3; ++i) kg[i] = *(const u32x4*)(kn + kro[i]);
#pragma unroll
                for (int i = 0; i < 2; ++i) vg[i] = *(const u32x4*)(vn + vro[i]); }
            const unsigned char* Kb = smem + cur * KBUF; const unsigned char* Vb = smem + VOFF + cur * VBUF;
            const int k0 = kt * 128;
            if (kt > 0 && k0 + 127 <= qw0) {
                f32x16 negm;
#pragma unroll
                for (int i = 0; i < 16; ++i) negm[i] = -mrun;
                f32x16 pa0, pa1, pb0, pb1;
#pragma unroll
                for (int d0 = 0; d0 < 6; ++d0) { const unsigned char* kp = Kb + r32 * 208 + (16 * d0 + 8 * hi) * 2;
                    const bf16x8 k0f = *(const bf16x8*)kp, k1f = *(const bf16x8*)(kp + 32 * 208);
                    pa0 = MFMA32(k0f, qf[d0], d0 == 0 ? negm : pa0); pa1 = MFMA32(k1f, qf[d0], d0 == 0 ? negm : pa1); }
                float ps = 0.f;
                const int co = (16 * blk16 + 4 * pp) * 2;
#pragma unroll
                for (int s = 0; s < 8; ++s) {
                    ATTN_SB();
                    float e[8];
#pragma unroll
                    for (int j = 0; j < 8; ++j) { const int ix = (s & 1) * 8 + j; const float v = (s >> 1) == 0 ? pa0[ix] : (s >> 1) == 1 ? pa1[ix] : (s >> 1) == 2 ? pb0[ix] : pb1[ix]; e[j] = ex2(v); ps += e[j]; }
                    const bf16x8 pk = pack8(e[0], e[1], e[2], e[3], e[4], e[5], e[6], e[7]);
                    if (s < 4) {
#pragma unroll
                        for (int t = 0; t < 3; ++t) { const int m = 3 * s + t, d0 = m >> 1, wh = m & 1;
                            const bf16x8 kf = *(const bf16x8*)(Kb + (64 + 32 * wh + r32) * 208 + (16 * d0 + 8 * hi) * 2);
                            if (wh == 0) pb0 = MFMA32(kf, qf[d0], d0 == 0 ? negm : pb0); else pb1 = MFMA32(kf, qf[d0], d0 == 0 ? negm : pb1); } }
                    const int rowk = 16 * s + 4 * hi;
                    const bf16x8 va0 = cat8(trrd(Vb + (rowk + q4) * 192 + co), trrd(Vb + (rowk + 8 + q4) * 192 + co));
                    const bf16x8 va1 = cat8(trrd(Vb + (rowk + q4) * 192 + 64 + co), trrd(Vb + (rowk + 8 + q4) * 192 + 64 + co));
                    o0 = MFMA32(va0, pk, o0); o1 = MFMA32(va1, pk, o1);
                }
                lsum += ps;
                const float pr = ps + __shfl_xor(ps, 32);
                if (__any(pr > 65536.f)) { const float d = pr > 65536.f ? floorf(__log2f(pr)) : 0.f; mrun += d; const float sc = ex2(-d); lsum *= sc;
#pragma unroll
                    for (int i = 0; i < 16; ++i) { o0[i] *= sc; o1[i] *= sc; } }
            } else {
#pragma unroll
                for (int sub = 0; sub < 2; ++sub) { const int ks = k0 + 64 * sub;
                    if (ks <= qw0 + 31) attn_step64(Kb + sub * 64 * 208, Vb + sub * 64 * 192, qf, o0, o1, mrun, lsum, ks, qw0 + r32, ks + 63 > qw0, r32, hi, q4, pp, blk16); }
            }
            if (more) { unsigned char* Kn = smem + (cur ^ 1) * KBUF; unsigned char* Vn = smem + VOFF + (cur ^ 1) * VBUF;
#pragma unroll
                for (int i = 0; i < 3; ++i) *(u32x4*)(Kn + klo[i]) = kg[i];
#pragma unroll
                for (int i = 0; i < 2; ++i) *(u32x4*)(Vn + vlo[i]) = vg[i]; }
            __syncthreads();
        }
        const float lt = lsum + __shfl_xor(lsum, 32); const float inv = 1.f / lt;
        const size_t row = rowb + qw0 + r32;
#pragma unroll
        for (int dvh = 0; dvh < 2; ++dvh)
#pragma unroll
            for (int g4 = 0; g4 < 4; ++g4) { const int dv = 32 * dvh + 8 * g4 + 4 * hi; const size_t o = row * 512 + h * 64 + dv;
                const u32x2 gv = *(const u32x2*)(GM + o); float g[4] = {lo16(gv.x), hi16(gv.x), lo16(gv.y), hi16(gv.y)}; float y[4];
#pragma unroll
                for (int j = 0; j < 4; ++j) { const float ov = (dvh ? o1[4 * g4 + j] : o0[4 * g4 + j]) * inv; y[j] = ov * g[j] * sigm(g[j]); }
                u32x2 w = {pk2(y[0], y[1]), pk2(y[2], y[3])}; *(u32x2*)(Y + o) = w; }
    }
}

DI void ret_pass2(PP p, int l, unsigned char* smem, int lane, int wave, int blk, int G) {
    bf16_t* Vimg = (bf16_t*)(smem + wave * 6144);
    bf16_t* RQ = (bf16_t*)(p->ws + WS_RQ); const bf16_t* RK = (const bf16_t*)(p->ws + WS_RK); const bf16_t* RV = (const bf16_t*)(p->ws + WS_RV);
    const bf16_t* GR = (const bf16_t*)(p->ws + WS_GRET); const float* CKV = (const float*)(p->ws + WS_CKV); const float* gng = p->in[15] + l * 512;
    const int r32 = lane & 31, hi = lane >> 5, q4 = (lane & 15) >> 2, pp = lane & 3, blk16 = (lane >> 4) & 1;
    for (int u = blk * 8 + wave; u < 2048; u += G * 8) {
        const int h = u & 7, n = (u >> 3) & 63, b = u >> 9;
        const float l2g = log2f(1.f - exp2f(-5.f - (float)h));
        const size_t rowbase = (size_t)b * S + n * 128;
        const float* prev = CKV + ((size_t)(b * 64 + n) * 8 + h) * 4096;
        bf16x8 pf[2][4];
#pragma unroll
        for (int eh = 0; eh < 2; ++eh)
#pragma unroll
            for (int ks = 0; ks < 4; ++ks) { const float* s = prev + (16 * ks + 8 * hi) * 64 + 32 * eh + r32;
                pf[eh][ks] = pack8(s[0], s[64], s[128], s[192], s[256], s[320], s[384], s[448]); }
        for (int it = 0; it < 4; ++it) {
            f32x16 oT[2];
#pragma unroll
            for (int r = 0; r < 16; ++r) { oT[0][r] = 0.f; oT[1][r] = 0.f; }
            const size_t qrow = rowbase + 32 * it + r32;
            bf16x8 qf[4];
#pragma unroll
            for (int ks = 0; ks < 4; ++ks) qf[ks] = *(const bf16x8*)(RQ + qrow * 512 + 64 * h + 16 * ks + 8 * hi);
            for (int jt = 0; jt <= it; ++jt) {
#pragma unroll
                for (int c4 = 0; c4 < 4; ++c4) { const int idx = c4 * 64 + lane, tl = idx >> 3, cc = idx & 7;
                    *(u32x4*)(Vimg + tl * 96 + cc * 8) = *(const u32x4*)(RV + (rowbase + 32 * jt + tl) * 512 + 64 * h + cc * 8); }
                f32x16 sT;
#pragma unroll
                for (int r = 0; r < 16; ++r) sT[r] = 0.f;
                const size_t krow = rowbase + 32 * jt + r32;
#pragma unroll
                for (int ks = 0; ks < 4; ++ks) { const bf16x8 kf = *(const bf16x8*)(RK + krow * 512 + 64 * h + 16 * ks + 8 * hi); sT = MFMA32(kf, qf[ks], sT); }
                const int il = 32 * it + r32;
#pragma unroll
                for (int r = 0; r < 16; ++r) { const int dd = il - (32 * jt + crow(r, hi)); sT[r] = dd >= 0 ? sT[r] * ex2((float)dd * l2g) : 0.f; }
                LDS_FENCE();
#pragma unroll
                for (int s = 0; s < 2; ++s) {
                    const bf16x8 pb = s == 0 ? pack8(sT[0], sT[1], sT[2], sT[3], sT[4], sT[5], sT[6], sT[7]) : pack8(sT[8], sT[9], sT[10], sT[11], sT[12], sT[13], sT[14], sT[15]);
                    const int rowk = 16 * s + 4 * hi;
#pragma unroll
                    for (int eh = 0; eh < 2; ++eh) { const int co = 32 * eh + 16 * blk16 + 4 * pp;
                        const bf16x8 va = cat8(trrd(Vimg + (rowk + q4) * 96 + co), trrd(Vimg + (rowk + 8 + q4) * 96 + co));
                        oT[eh] = MFMA32(va, pb, oT[eh]); }
                }
                LDS_FENCE();
            }
            f32x16 cT[2];
#pragma unroll
            for (int r = 0; r < 16; ++r) { cT[0][r] = 0.f; cT[1][r] = 0.f; }
#pragma unroll
            for (int eh = 0; eh < 2; ++eh)
#pragma unroll
                for (int ks = 0; ks < 4; ++ks) cT[eh] = MFMA32(pf[eh][ks], qf[ks], cT[eh]);
            const float qw = ex2((float)(32 * it + r32 + 1) * l2g);
            float s1 = 0.f;
#pragma unroll
            for (int r = 0; r < 16; ++r) { oT[0][r] += qw * cT[0][r]; oT[1][r] += qw * cT[1][r]; s1 += oT[0][r] + oT[1][r]; }
            s1 += __shfl_xor(s1, 32); const float mu = s1 * (1.f / 64.f);
            float s2 = 0.f;
#pragma unroll
            for (int r = 0; r < 16; ++r) { const float d0 = oT[0][r] - mu, d1 = oT[1][r] - mu; s2 += d0 * d0 + d1 * d1; }
            s2 += __shfl_xor(s2, 32); const float rstd = rsqrtf(s2 * (1.f / 64.f) + 1e-5f);
#pragma unroll
            for (int eh = 0; eh < 2; ++eh)
#pragma unroll
                for (int g4 = 0; g4 < 4; ++g4) { const int e = 32 * eh + 8 * g4 + 4 * hi; const size_t o = qrow * 512 + 64 * h + e;
                    const f32x4 gn = *(const f32x4*)(gng + 64 * h + e); const u32x2 gv = *(const u32x2*)(GR + o);
                    const float g[4] = {lo16(gv.x), hi16(gv.x), lo16(gv.y), hi16(gv.y)}; float y[4];
#pragma unroll
                    for (int j = 0; j < 4; ++j) y[j] = (oT[eh][4 * g4 + j] - mu) * rstd * gn[j] * g[j] * sigm(g[j]);
                    u32x2 w = {pk2(y[0], y[1]), pk2(y[2], y[3])}; *(u32x2*)(RQ + o) = w; }
        }
    }
}

DI void ln_phase(PP p, int l, bool write_xb, int lane, int wave, int blk, int G) {
    float* out = p->out; const float* lnst = (const float*)(p->ws + WS_LNST); bf16_t* XB = (bf16_t*)(p->ws + WS_XB);
    const float* g = p->in[18] + l * 1024; const float* bb = p->in[19] + l * 1024;
    for (int row = blk * 8 + wave; row < M; row += G * 8) {
        float s1 = 0.f, s2 = 0.f;
        if (lane < 16) { const f32x2 v = *(const f32x2*)(lnst + ((size_t)row * 16 + lane) * 2); s1 = v.x; s2 = v.y; }
#pragma unroll
        for (int o = 1; o < 16; o <<= 1) { s1 += __shfl_xor(s1, o); s2 += __shfl_xor(s2, o); }
        s1 = __shfl(s1, 0); s2 = __shfl(s2, 0);
        const float mean = s1 * (1.f / 1024.f); const float var = fmaxf(s2 * (1.f / 1024.f) - mean * mean, 0.f); const float rstd = rsqrtf(var + 1e-5f);
#pragma unroll
        for (int j = 0; j < 4; ++j) { const int c = 4 * lane + 256 * j; const size_t o = (size_t)row * 1024 + c;
            const f32x4 t = *(const f32x4*)(out + o), gv = *(const f32x4*)(g + c), bv = *(const f32x4*)(bb + c); f32x4 y;
#pragma unroll
            for (int e = 0; e < 4; ++e) y[e] = (t[e] - mean) * rstd * gv[e] + bv[e];
            *(f32x4*)(out + o) = y;
            if (write_xb) { u32x2 w = {pk2(y[0], y[1]), pk2(y[2], y[3])}; *(u32x2*)(XB + o) = w; } }
    }
}

#define XLAS __attribute__((address_space(3)))
#define XB_TMO      128
#define XB_XCNT(j)  (256  + 64 * (j))
#define XB_XSUB(j)  (1280 + 64 * (j))
#define XB_XGEN(j)  (2304 + 64 * (j))
#define XB_TOP      3328
#define XB_TOPGEN   3392
#define XCD_BAR_WORDS 3456
#define XB_SPIN_CAP (1u << 18)

__device__ __forceinline__ unsigned xb_ld(unsigned* p)              { return __hip_atomic_load(p, __ATOMIC_RELAXED, __HIP_MEMORY_SCOPE_AGENT); }
__device__ __forceinline__ unsigned xb_add(unsigned* p, unsigned v) { return __hip_atomic_fetch_add(p, v, __ATOMIC_RELAXED, __HIP_MEMORY_SCOPE_AGENT); }
__device__ __forceinline__ unsigned xb_xcc_id() { return (unsigned)__builtin_amdgcn_s_getreg((3 << 11) | 20) & 0xFu; }
#define XB_SPIN(cond, bar) do { unsigned _sp = 0; while (cond) { __builtin_amdgcn_s_sleep(1); \
    if ((++_sp & 255u) == 0u) { if (xb_ld(&(bar)[XB_TMO])) break; if (_sp > XB_SPIN_CAP) { atomicAdd(&(bar)[XB_TMO], 1u); break; } } } } while (0)

struct XcdBarrier {
    unsigned* bar; unsigned x;
    volatile XLAS unsigned* st;
};

__device__ __forceinline__ XcdBarrier xcd_barrier_post(unsigned* bar, volatile XLAS unsigned* st) {
    XcdBarrier b; b.bar = bar; b.x = xb_xcc_id(); b.st = st;
    if (threadIdx.x == 0) (void)xb_add(&bar[XB_XCNT(b.x)], 1u);
    return b;
}
__device__ __forceinline__ void xcd_barrier_complete(unsigned* bar, unsigned x, unsigned& nloc, unsigned& nx) {
    const unsigned G = gridDim.x * gridDim.y * gridDim.z;
    unsigned sum, cnt, mine, sp = 0u;
    for (;;) {
        sum = 0u; cnt = 0u; mine = 0u;
#pragma unroll
        for (unsigned j = 0; j < 16; ++j) { const unsigned c = xb_ld(&bar[XB_XCNT(j)]); sum += c; cnt += (c > 0u) ? 1u : 0u; mine = (j == x) ? c : mine; }
        if (sum == G) break;
        __builtin_amdgcn_s_sleep(1);
        if ((++sp & 255u) == 0u) { if (xb_ld(&bar[XB_TMO])) break; if (sp > XB_SPIN_CAP) { atomicAdd(&bar[XB_TMO], 1u); break; } }
    }
    nloc = mine > 0u ? mine : 1u; nx = cnt > 0u ? cnt : 1u;
}

__device__ __forceinline__ void xcd_barrier(const XcdBarrier& b) {
    asm volatile("s_waitcnt vmcnt(0)" ::: "memory");
    __syncthreads();
    if (threadIdx.x == 0) {
        unsigned* bar = b.bar;
        __builtin_amdgcn_s_waitcnt(0);
        unsigned nloc = b.st[0], nx = b.st[1];
        if (nloc == 0u) { xcd_barrier_complete(bar, b.x, nloc, nx); b.st[0] = nloc; b.st[1] = nx; }
        const unsigned old = xb_add(&bar[XB_XSUB(b.x)], 1u);
        const unsigned gen = old / nloc;
        if (old + 1u == (gen + 1u) * nloc) {
            __builtin_amdgcn_fence(__ATOMIC_RELEASE, "agent");
            asm volatile("s_waitcnt vmcnt(0)" ::: "memory");
            const unsigned og = xb_add(&bar[XB_TOP], 1u);
            const unsigned tg = og / nx;
            if (og + 1u == (tg + 1u) * nx) xb_add(&bar[XB_TOPGEN], 1u);
            else XB_SPIN(xb_ld(&bar[XB_TOPGEN]) == tg, bar);
            __builtin_amdgcn_fence(__ATOMIC_ACQUIRE, "agent");
            xb_add(&bar[XB_XGEN(b.x)], 1u);
            asm volatile("s_waitcnt vmcnt(0)" ::: "memory");
        } else {
            XB_SPIN(xb_ld(&bar[XB_XGEN(b.x)]) == gen, bar);
            __builtin_amdgcn_fence(__ATOMIC_ACQUIRE, "agent");
            asm volatile("s_waitcnt vmcnt(0)" ::: "memory");
        }
    }
    __syncthreads();
}


#define PH() do { asm volatile("" : "+v"(tid)); asm volatile("" : "+s"(q)); ws = q->ws; lane = tid & 63; wave = __builtin_amdgcn_readfirstlane(tid >> 6); } while (0)
template <int l> DI void run_layer(unsigned char* smem, const XcdBarrier& xbar) {
    int tid = threadIdx.x, lane = tid & 63, wave = __builtin_amdgcn_readfirstlane(tid >> 6);
    const int G = gridDim.x, blk = blockIdx.x;
    PG8_LAS unsigned char* glds = (PG8_LAS unsigned char*)smem;
    PP q = (PP)__builtin_amdgcn_kernarg_segment_ptr();
    unsigned char* ws = q->ws;
        const unsigned char* wl = ws + WS_W + (size_t)l * W_LAYER;
        const float* xcur = (l == 0) ? q->in[0] : q->out;
        PH(); if (PHM & 2) { pg8::Gemm g{(const bf16_t*)(ws + WS_XB), (const bf16_t*)(wl + W_IN), M, 4352, 1024}; pg8::StaticOrder so; so.init(M, 4352, G, blk);
          EpiZ E{ws}; pg8::gemm_phase<EpiZ, pg8::StaticOrder, true, true>(glds, g, so, E); }
        xcd_barrier(xbar);
        PH(); if (PHM & 4) { pg8::Gemm g{(const bf16_t*)(ws + WS_ZQ), (const bf16_t*)(wl + W_UQ), M, 768, 512}; pg8::StaticOrder so; so.init(M, 768, G, blk);
          EpiQ E{(const float*)(ws + WS_SSQ), (const int*)q->in[1], (bf16_t*)(ws + WS_XB)}; pg8::gemm_phase<EpiQ, pg8::StaticOrder, true, true>(glds, g, so, E); }
        PH(); if (PHM & 8) { pg8::Gemm g{(const bf16_t*)(ws + WS_ZKV), (const bf16_t*)(wl + W_UKV), M, 1024, 256}; pg8::StaticOrder so; so.init(M, 1024, G, blk);
          EpiKV E{(const float*)(ws + WS_SSKV), (bf16_t*)(ws + WS_KF), (bf16_t*)(ws + WS_V)}; pg8::gemm_phase<EpiKV, pg8::StaticOrder, true, true>(glds, g, so, E); }
        __syncthreads();
        PH(); if (PHM & 16) krot_phase(q, blk * 512 + tid, G * 512);
        PH(); if (PHM & 32) lru_pass<false>(q, l, smem, tid, lane, wave, blk, G);
        __syncthreads();
        PH(); if (PHM & 64) ret_pass1(q, smem, lane, wave, blk, G);
        xcd_barrier(xbar);
        PH(); if (PHM & 128) ret_prefix(q, blk * 512 + tid, G * 512);
        PH(); if (PHM & 256) lru_pass<true>(q, l, smem, tid, lane, wave, blk, G);
        __syncthreads();
        PH(); if (PHM & 512) attn_phase(q, smem, tid, lane, wave, blk, G);
        xcd_barrier(xbar);
        PH(); if (PHM & 1024) ret_pass2(q, l, smem, lane, wave, blk, G);
        cvt_rows_bf16(xcur, (bf16_t*)(ws + WS_XB), blk * 512 + tid, G * 512);
        xcd_barrier(xbar);
        PH(); if (PHM & 2048) { pg8::Gemm g{(const bf16_t*)(ws + WS_XB), (const bf16_t*)(wl + W_G), M, 3072, 1024}; pg8::StaticOrder so; so.init(M, 3072, G, blk);
          EpiGate E{q->in[3] + l * 3072, (bf16_t*)(ws + WS_GP)}; pg8::gemm_phase<EpiGate, pg8::StaticOrder, true, true>(glds, g, so, E); }
        xcd_barrier(xbar);
        PH(); if (PHM & 4096) for (int br = 0; br < 3; ++br) {
            const size_t yoff = br == 0 ? WS_ZQ : br == 1 ? WS_GLRU : WS_RQ;
            pg8::Gemm g{(const bf16_t*)(ws + yoff), (const bf16_t*)(wl + W_B) + (size_t)br * 1024 * 512, M, 1024, 512}; pg8::StaticOrder so; so.init(M, 1024, G, blk);
            EpiP E{(const bf16_t*)(ws + WS_GP), (bf16_t*)(ws + WS_MIX), br}; pg8::gemm_phase<EpiP, pg8::StaticOrder, true, true>(glds, g, so, E);
        }
        xcd_barrier(xbar);
        PH(); if (PHM & 8192) { pg8::Gemm g{(const bf16_t*)(ws + WS_MIX), (const bf16_t*)(wl + W_O3), M, 1024, 1024}; pg8::StaticOrder so; so.init(M, 1024, G, blk);
          EpiOut E{xcur, q->out, (float*)(ws + WS_LNST)}; pg8::gemm_phase<EpiOut, pg8::StaticOrder, true, true>(glds, g, so, E); }
        xcd_barrier(xbar);
        PH(); if (PHM & 16384) ln_phase(q, l, l + 1 < DEPTH, lane, wave, blk, G);
        if (l + 1 < DEPTH) xcd_barrier(xbar);
}

__global__ void __launch_bounds__(512, 2) mega_fwd(Params p) {
    extern __shared__ __attribute__((aligned(16))) unsigned char smem[];
    cg::grid_group grid = cg::this_grid();
    volatile XLAS unsigned* xst = (volatile XLAS unsigned*)(smem + LDS_BYTES - 16);
    if (threadIdx.x < 4) xst[threadIdx.x] = 0u;
    __syncthreads();
    if (blockIdx.x == 0) { unsigned* bw = (unsigned*)(((PP)__builtin_amdgcn_kernarg_segment_ptr())->ws + WS_BAR); for (int i = threadIdx.x; i < XCD_BAR_WORDS; i += 512) bw[i] = 0u; }
    {
        int tid = threadIdx.x, lane = tid & 63, wave = __builtin_amdgcn_readfirstlane(tid >> 6);
        const int G = gridDim.x, blk = blockIdx.x;
        PP q = (PP)__builtin_amdgcn_kernarg_segment_ptr();
        unsigned char* ws = q->ws;
        PH(); if (PHM & 1) phase0(q, smem, tid, lane, wave, blk, G);
        grid.sync();
    }
    const XcdBarrier xbar = xcd_barrier_post((unsigned*)(((PP)__builtin_amdgcn_kernarg_segment_ptr())->ws + WS_BAR), xst);
    run_layer<0>(smem, xbar);
    run_layer<1>(smem, xbar);
}

extern "C" void kernel_launch(void* const* d_in, const int* in_sizes, int n_in, void* d_out, int out_size, void* d_ws, size_t ws_size, hipStream_t stream) {
    static int grid_blocks = 0;
    if (grid_blocks == 0) {
        if (n_in != 20 || out_size != M * 1024 || ws_size < WS_END) { fprintf(stderr, "kernel_launch: unexpected shapes (n_in %d out %d ws %zu)\n", n_in, out_size, ws_size); grid_blocks = -1; return; }
        int dev = 0, cus = 0, per_cu = 0;
        hipGetDevice(&dev); hipDeviceGetAttribute(&cus, hipDeviceAttributeMultiprocessorCount, dev);
        if (hipFuncSetAttribute((const void*)mega_fwd, hipFuncAttributeMaxDynamicSharedMemorySize, LDS_BYTES) != hipSuccess) { fprintf(stderr, "kernel_launch: hipFuncSetAttribute failed\n"); }
        if (hipOccupancyMaxActiveBlocksPerMultiprocessor(&per_cu, (const void*)mega_fwd, 512, LDS_BYTES) != hipSuccess || per_cu < 1) { fprintf(stderr, "kernel_launch: occupancy query says %d\n", per_cu); per_cu = 1; }
        (void)hipGetLastError();
        grid_blocks = cus;
    }
    if (grid_blocks < 0) return;
    Params p{};
    for (int i = 0; i < 20; ++i) p.in[i] = (const float*)d_in[i];
    p.out = (float*)d_out; p.ws = (unsigned char*)d_ws;
    void* args[] = {&p};
    hipError_t e = hipLaunchCooperativeKernel((const void*)mega_fwd, dim3(grid_blocks), dim3(512), args, LDS_BYTES, stream);
    if (e != hipSuccess) fprintf(stderr, "cooperative launch failed: %s (grid %d)\n", hipGetErrorString(e), grid_blocks);
}
```
